# Optimizing an MI355X kernel written in HIP

```python
import jax, jax.numpy as jnp
from jax import lax
import numpy as np

D_MODEL = 1024
BATCH = 8
SEQ = 4096
DEPTH = 1

CHUNK = 128
SGU_GROUPS = 8
SGU_GROUP_DIM = D_MODEL // SGU_GROUPS
SGU_WIDTH = SGU_GROUPS * SGU_GROUP_DIM
ATTN_HEADS = 8
ATTN_HEAD_DIM = 128
ATTN_WIDTH = ATTN_HEADS * ATTN_HEAD_DIM
IDX_HEADS = 8
IDX_DIM = 64
IDX_TOPK_MAX = 256
QUERY_BLOCK = 64
FFN_DIM = 4 * D_MODEL
ALPHA = (2.0 * DEPTH) ** 0.25
BETA = (8.0 * DEPTH) ** -0.25
LN_EPS = 1e-5
IN_SPLITS = (SGU_WIDTH, SGU_WIDTH, ATTN_WIDTH, ATTN_WIDTH, ATTN_WIDTH,
             IDX_HEADS * IDX_DIM, IDX_DIM, IDX_HEADS, D_MODEL, D_MODEL)
IN_WIDTH = sum(IN_SPLITS)

kernel_name = "hybrid_gmlp_dsa_gated_deepnorm"


def layer_norm(x, g, b):
    xf = x.astype(jnp.float32)
    mu = jnp.mean(xf, axis=-1, keepdims=True)
    xc = xf - mu
    var = jnp.mean(xc * xc, axis=-1, keepdims=True)
    return (xc * lax.rsqrt(var + LN_EPS) * g.astype(jnp.float32) + b.astype(jnp.float32)).astype(x.dtype)


def sgu_mixer(u, v, ln_g, ln_b, w_s, b_s):
    bsz, seq, _ = v.shape
    u = jax.nn.gelu(u)
    v = layer_norm(jax.nn.gelu(v), ln_g, ln_b)
    v = v.reshape(bsz, seq // CHUNK, CHUNK, SGU_GROUPS, SGU_GROUP_DIM)
    causal = jnp.tril(jnp.ones((CHUNK, CHUNK), dtype=bool))
    w = jnp.where(causal[None], w_s, jnp.zeros_like(w_s))
    s = jnp.einsum('gts,bnsgc->bntgc', w, v) + b_s.T[None, None, :, :, None]
    return u * s.reshape(bsz, seq, SGU_WIDTH)


def dsa_mixer(q, k, v, q_idx, k_idx, w_idx):
    bsz, seq, _ = q.shape
    top_k = min(IDX_TOPK_MAX, seq // 4)
    q = q.reshape(bsz, seq, ATTN_HEADS, ATTN_HEAD_DIM)
    k = k.reshape(bsz, seq, ATTN_HEADS, ATTN_HEAD_DIM)
    v = v.reshape(bsz, seq, ATTN_HEADS, ATTN_HEAD_DIM)
    q_idx = q_idx.reshape(bsz, seq, IDX_HEADS, IDX_DIM)
    w_idx = w_idx * (IDX_HEADS ** -0.5 * IDX_DIM ** -0.5)
    key_pos = jnp.arange(seq)
    gather = jax.vmap(lambda arr, ids: arr[ids])

    def block(start):
        qb = lax.dynamic_slice_in_dim(q, start, QUERY_BLOCK, axis=1)
        qib = lax.dynamic_slice_in_dim(q_idx, start, QUERY_BLOCK, axis=1)
        wb = lax.dynamic_slice_in_dim(w_idx, start, QUERY_BLOCK, axis=1)
        q_pos = start + jnp.arange(QUERY_BLOCK)
        causal = key_pos[None, :] <= q_pos[:, None]
        logits = jnp.einsum('bthd,bsd->bths', qib, k_idx)
        score = jnp.einsum('bth,bths->bts', wb, jax.nn.relu(logits)).astype(jnp.float32)
        score = jnp.where(causal[None], score, -jnp.inf)
        _, idx = lax.top_k(score, top_k)
        valid = idx <= q_pos[None, :, None]
        kg = gather(k, idx)
        vg = gather(v, idx)
        att = jnp.einsum('bthd,btkhd->bthk', qb, kg).astype(jnp.float32) * (ATTN_HEAD_DIM ** -0.5)
        att = jnp.where(valid[:, :, None, :], att, -jnp.inf)
        p = jax.nn.softmax(att, axis=-1).astype(v.dtype)
        return jnp.einsum('bthk,btkhd->bthd', p, vg)

    starts = jnp.arange(0, seq, QUERY_BLOCK)
    out = lax.map(block, starts)
    return out.transpose(1, 0, 2, 3, 4).reshape(bsz, seq, ATTN_WIDTH)


def hybrid_layer(x, w_in, sgu_ln_g, sgu_ln_b, sgu_w, sgu_b, w_branch_a, w_branch_b, w_out,
                 ln1_g, ln1_b, w_ffn_up, w_ffn_down, ln2_g, ln2_b):
    proj = x @ w_in
    offsets = [int(o) for o in np.cumsum(IN_SPLITS)[:-1]]
    u_a, v_a, q, k, v, q_idx, k_idx, w_idx, g_a, g_b = jnp.split(proj, offsets, axis=-1)
    a = sgu_mixer(u_a, v_a, sgu_ln_g, sgu_ln_b, sgu_w, sgu_b)
    b = dsa_mixer(q, k, v, q_idx, k_idx, w_idx)
    merged = jax.nn.sigmoid(g_a) * (a @ w_branch_a) + jax.nn.sigmoid(g_b) * (b @ w_branch_b)
    x = layer_norm(ALPHA * x + merged @ w_out, ln1_g, ln1_b)
    h = jnp.square(jax.nn.relu(x @ w_ffn_up))
    return layer_norm(ALPHA * x + h @ w_ffn_down, ln2_g, ln2_b)


def setup_inputs(seed: int = 0) -> dict:
    key = jax.random.key(seed)
    ks = jax.random.split(key, 16)
    n = lambda k, shape: jax.random.normal(k, shape, dtype=jnp.float32)
    L = DEPTH
    return {
        "x": n(ks[0], (BATCH, SEQ, D_MODEL)),
        "w_in": n(ks[1], (L, D_MODEL, IN_WIDTH)) * D_MODEL ** -0.5,
        "sgu_ln_g": 1.0 + 0.02 * n(ks[2], (L, SGU_WIDTH)),
        "sgu_ln_b": 0.02 * n(ks[3], (L, SGU_WIDTH)),
        "sgu_w": n(ks[4], (L, SGU_GROUPS, CHUNK, CHUNK)) * CHUNK ** -0.5,
        "sgu_b": 1.0 + 0.02 * n(ks[5], (L, SGU_GROUPS, CHUNK)),
        "w_branch_a": n(ks[6], (L, D_MODEL, D_MODEL)) * (D_MODEL ** -0.5 * BETA),
        "w_branch_b": n(ks[7], (L, ATTN_WIDTH, D_MODEL)) * (ATTN_WIDTH ** -0.5 * BETA),
        "w_out": n(ks[8], (L, D_MODEL, D_MODEL)) * (D_MODEL ** -0.5 * BETA),
        "ln1_g": 1.0 + 0.02 * n(ks[9], (L, D_MODEL)),
        "ln1_b": 0.02 * n(ks[10], (L, D_MODEL)),
        "w_ffn_up": n(ks[11], (L, D_MODEL, FFN_DIM)) * D_MODEL ** -0.5,
        "w_ffn_down": n(ks[12], (L, FFN_DIM, D_MODEL)) * (FFN_DIM ** -0.5 * BETA),
        "ln2_g": 1.0 + 0.02 * n(ks[13], (L, D_MODEL)),
        "ln2_b": 0.02 * n(ks[14], (L, D_MODEL)),
    }


def reference(x, w_in, sgu_ln_g, sgu_ln_b, sgu_w, sgu_b, w_branch_a, w_branch_b, w_out,
              ln1_g, ln1_b, w_ffn_up, w_ffn_down, ln2_g, ln2_b):
    for i in range(DEPTH):
        x = hybrid_layer(x, w_in[i], sgu_ln_g[i], sgu_ln_b[i], sgu_w[i], sgu_b[i],
                         w_branch_a[i], w_branch_b[i], w_out[i], ln1_g[i], ln1_b[i],
                         w_ffn_up[i], w_ffn_down[i], ln2_g[i], ln2_b[i])
    return x
```

```cpp
#include <hip/hip_runtime.h>
#include <hip/hip_bf16.h>
#include <cstdio>
#include <cstdint>

#ifndef PH_MASK
#define PH_MASK 0xfff
#endif
#ifndef DUP_PHASE
#define DUP_PHASE -1
#endif
#ifndef MK_N_LAUNCHES
#define MK_N_LAUNCHES 1
#endif

namespace pg8 {
#define PG8_LAS __attribute__((address_space(3)))
typedef unsigned short bf16_t;
typedef short bf16x8 __attribute__((ext_vector_type(8)));
typedef float f32x4 __attribute__((ext_vector_type(4)));
typedef float f32x2 __attribute__((ext_vector_type(2)));
typedef unsigned u32x4 __attribute__((ext_vector_type(4)));
typedef unsigned u32x2 __attribute__((ext_vector_type(2)));
constexpr int BM = 256, BK = 64, HALF = 128, HTB = HALF * BK * 2  , STAGE_BYTES = 8 * HTB, NXCD = 8, WGM = 8;

__host__ __device__ __forceinline__ int lds_byte(int r, int c) { const int st = (r >> 4) * 2 + (c >> 5), rr = r & 15, cc = c & 31, ob = rr * 64 + cc * 2; return st * 1024 + (ob ^ (((ob >> 9) & 1) << 5)); }
__host__ __device__ __forceinline__ void stage_rc(int b, int& R, int& C) { const int st = b / 1024, sb = b % 1024, swz = sb ^ (((sb >> 9) & 1) << 5); R = (st >> 1) * 16 + swz / 64; C = (st & 1) * 32 + (swz % 64) / 2; }
__host__ __device__ __forceinline__ int perm32(int rho) { const int n = rho >> 4, i = rho & 15; return 8 * (i >> 2) + 4 * n + (i & 3); }

struct Unit { int pm, pn, kind; };

struct StaticOrder {
    int nM, nN, nwg, G, c;
    __device__ __forceinline__ void init(int nM_, int nN_, int G_, int c_) { nM = nM_; nN = nN_; nwg = nM * nN; G = G_; c = c_; }
    __device__ __forceinline__ bool next_mn(int i, int& pm, int& pn) const {
        const long L = (long)i * G + c; if (L >= nwg) return false;
        int wgid = (int)L; { const int q = nwg / NXCD, r = nwg % NXCD, xcd = wgid % NXCD, off = wgid / NXCD; wgid = (xcd < r ? xcd * (q + 1) : r * (q + 1) + (xcd - r) * q) + off; }
        const int nig = WGM * nN, gid = wgid / nig, fm = gid * WGM, gsz = (nM - fm) < WGM ? (nM - fm) : WGM;
        pm = fm + ((wgid % nig) % gsz); pn = (wgid % nig) / gsz; return true;
    }
};
struct PlainSched : StaticOrder {
    const char* A; const char* B; size_t tstep;
    __device__ __forceinline__ void setup(const void* A_, const void* B_, int M, int N, int K, int G_, int c_) { A = (const char*)A_; B = (const char*)B_; tstep = (size_t)BM * K * 2; init(M / BM, N / BM, G_, c_); }
    __device__ __forceinline__ bool next(int i, Unit& u) const { u.kind = 0; return next_mn(i, u.pm, u.pn); }
    __device__ __forceinline__ const char* aptr(const Unit& u) const { return A + (size_t)u.pm * tstep; }
    __device__ __forceinline__ const char* bptr(const Unit& u) const { return B + (size_t)u.pn * tstep; }
};

__device__ __forceinline__ unsigned cvt_pk_bf16(float lo, float hi) { unsigned r; asm volatile("v_cvt_pk_bf16_f32 %0, %1, %2" : "=v"(r) : "v"(lo), "v"(hi)); return r; }
__device__ __forceinline__ float bf_lo(unsigned w) { return __uint_as_float(w << 16); }
__device__ __forceinline__ float bf_hi(unsigned w) { return __uint_as_float(w & 0xffff0000u); }
__device__ __forceinline__ float gelu_tanh(float x) {
    const float z = x * (-2.302208198f) * fmaf(0.044715f * x, x, 1.0f);
    return x * __builtin_amdgcn_rcpf(1.0f + __builtin_amdgcn_exp2f(z));
}
__device__ __forceinline__ float sigmoidf_(float x) { return __builtin_amdgcn_rcpf(1.0f + __builtin_amdgcn_exp2f(x * (-1.4426950409f))); }

template <class Epi, class Sched, bool ALIGN_EPI = true>
__device__ __forceinline__ void gemm_phase(PG8_LAS unsigned char* lds, const int K, const Sched& S, const Epi& E) {
    const int tid = threadIdx.x, wid = __builtin_amdgcn_readfirstlane(tid >> 6), lane = tid & 63, wr = wid >> 2, wc = wid & 3, fr = lane & 15, fq = lane >> 4;
    const int nt = K / BK;
    unsigned voffA[2], voffB[2];
#pragma unroll
    for (int i = 0; i < 2; ++i) { int R, C; stage_rc(tid * 16 + i * 8192, R, C); const int Rb = Epi::PERM ? ((R & ~31) + perm32(R & 31)) : R;
        voffA[i] = (unsigned)(R * K + C) * 2u; voffB[i] = (unsigned)(Rb * K + C) * 2u; }
    const size_t kstep = (size_t)(BK * 2);
    const size_t hstep = (size_t)HALF * K * 2;
    const unsigned ldsw = (unsigned)wid * 1024u;
    const int aoff = lds_byte(wr * 64 + fr, fq * 8), boff = lds_byte(wc * 32 + fr, fq * 8);
#define PG8_SA(b, h) (((b) * 2 + (h)) * HTB)
#define PG8_SB(b, h) ((4 + (b) * 2 + (h)) * HTB)
#define PG8_STAGE(bufoff, gbase, voff) do { _Pragma("unroll") for (int _i = 0; _i < 2; ++_i) \
        __builtin_amdgcn_global_load_lds((const unsigned*)((const char*)(gbase) + (voff)[_i]), (PG8_LAS unsigned*)(lds + (bufoff) + ldsw + _i * 8192), 16, 0, 0); } while (0)
#define PG8_LDA(dst, b, h) do { _Pragma("unroll") for (int m = 0; m < 4; ++m) _Pragma("unroll") for (int k = 0; k < 2; ++k) dst[m][k] = *(const PG8_LAS bf16x8*)(lds + PG8_SA(b, h) + aoff + m * 2048 + k * 1024); } while (0)
#define PG8_LDB(dst, b, h) do { _Pragma("unroll") for (int n = 0; n < 2; ++n) _Pragma("unroll") for (int k = 0; k < 2; ++k) dst[n][k] = *(const PG8_LAS bf16x8*)(lds + PG8_SB(b, h) + boff + n * 2048 + k * 1024); } while (0)
#define PG8_MMA(ai, bj, At, Bt) do { __builtin_amdgcn_s_setprio(1); _Pragma("unroll") for (int m = 0; m < 4; ++m) _Pragma("unroll") for (int n = 0; n < 2; ++n) _Pragma("unroll") for (int k = 0; k < 2; ++k) \
        acc[ai][bj][m][n] = __builtin_amdgcn_mfma_f32_16x16x32_bf16(Bt[n][k], At[m][k], acc[ai][bj][m][n], 0, 0, 0); __builtin_amdgcn_s_setprio(0); } while (0)
#define PG8_WAIT_V(n) asm volatile("s_waitcnt vmcnt(" #n ")" ::: "memory")
#define PG8_WAIT_L(n) asm volatile("s_waitcnt lgkmcnt(" #n ")" ::: "memory")
#define PG8_BAR __builtin_amdgcn_s_barrier()
#define PG8_SCHED __builtin_amdgcn_sched_barrier(0)
    Unit cur, nxt; int ui = 0;
    if (!S.next(0, cur)) return;
    f32x4 acc[2][2][4][2];
#pragma unroll
    for (int a = 0; a < 2; ++a)
#pragma unroll
        for (int b = 0; b < 2; ++b)
#pragma unroll
            for (int m = 0; m < 4; ++m)
#pragma unroll
                for (int n = 0; n < 2; ++n) acc[a][b][m][n] = (f32x4){0.f, 0.f, 0.f, 0.f};
    bf16x8 At[4][2], B0[2][2], B1[2][2];
    const char* cA = S.aptr(cur); const char* cB = S.bptr(cur);
    PG8_STAGE(PG8_SB(0, 0), cB, voffB); PG8_STAGE(PG8_SB(0, 1), cB + hstep, voffB); PG8_STAGE(PG8_SA(0, 0), cA, voffA); PG8_STAGE(PG8_SA(0, 1), cA + hstep, voffA);
    if (wr == 1) PG8_BAR;
    PG8_WAIT_V(2); PG8_BAR;
    PG8_STAGE(PG8_SB(1, 0), cB + kstep, voffB); PG8_STAGE(PG8_SA(1, 0), cA + kstep, voffA); PG8_STAGE(PG8_SB(1, 1), cB + hstep + kstep, voffB);
    PG8_WAIT_V(6); PG8_BAR;
    for (;;) {
        const bool has_next = S.next(ui + 1, nxt);
        const char* nA = has_next ? S.aptr(nxt) : cA; const char* nB = has_next ? S.bptr(nxt) : cB;
        unsigned td = 0u;
        if constexpr (Epi::TOUCH) E.touch(cur, tid, td);
        for (int t = 0; t < nt; t += 2) {
            const bool last = (t == nt - 2);
            const char* a1 = cA + (size_t)(t + 1) * kstep;
            const char* a2 = last ? nA : cA + (size_t)(t + 2) * kstep; const char* b2 = last ? nB : cB + (size_t)(t + 2) * kstep;
            const char* a3 = a2 + kstep; const char* b3 = b2 + kstep;
            PG8_LDB(B0, 0, 0); PG8_LDB(B1, 0, 1); PG8_SCHED; PG8_LDA(At, 0, 0); PG8_STAGE(PG8_SA(1, 1), a1 + hstep, voffA);
            PG8_WAIT_V(8); PG8_WAIT_L(0); PG8_BAR; PG8_MMA(0, 0, At, B0); PG8_MMA(0, 1, At, B1); PG8_BAR; PG8_SCHED;
            PG8_LDA(At, 0, 1); PG8_STAGE(PG8_SB(0, 0), b2, voffB); PG8_STAGE(PG8_SB(0, 1), b2 + hstep, voffB); PG8_STAGE(PG8_SA(0, 0), a2, voffA);
            PG8_WAIT_V(8); PG8_WAIT_L(0); PG8_BAR; PG8_MMA(1, 0, At, B0); PG8_MMA(1, 1, At, B1); PG8_BAR; PG8_SCHED;
            PG8_LDB(B0, 1, 0); PG8_LDB(B1, 1, 1); PG8_SCHED; PG8_LDA(At, 1, 0); PG8_STAGE(PG8_SA(0, 1), a2 + hstep, voffA);
            PG8_WAIT_V(8); PG8_WAIT_L(0); PG8_BAR; PG8_MMA(0, 0, At, B0); PG8_MMA(0, 1, At, B1); PG8_BAR; PG8_SCHED;
            PG8_LDA(At, 1, 1); PG8_STAGE(PG8_SB(1, 0), b3, voffB); PG8_STAGE(PG8_SB(1, 1), b3 + hstep, voffB); PG8_STAGE(PG8_SA(1, 0), a3, voffA);
            PG8_WAIT_V(8); PG8_WAIT_L(0); PG8_BAR; PG8_MMA(1, 0, At, B0); PG8_MMA(1, 1, At, B1); PG8_BAR; PG8_SCHED;
        }
        if constexpr (Epi::TOUCH) asm volatile("" :: "v"(td));
        if constexpr (ALIGN_EPI) { if (wr == 0) PG8_BAR; }
        E(acc, cur, wr, wc, fr, fq);
        if (!has_next) break;
#pragma unroll
        for (int a = 0; a < 2; ++a)
#pragma unroll
            for (int b = 0; b < 2; ++b)
#pragma unroll
                for (int m = 0; m < 4; ++m)
#pragma unroll
                    for (int n = 0; n < 2; ++n) acc[a][b][m][n] = (f32x4){0.f, 0.f, 0.f, 0.f};
        cur = nxt; cA = nA; cB = nB; ++ui;
        if constexpr (ALIGN_EPI) { if (wr == 1) PG8_BAR; }
    }
    PG8_WAIT_V(0);
    if constexpr (!ALIGN_EPI) { if (wr == 0) PG8_BAR; }
    PG8_BAR;
#undef PG8_SA
#undef PG8_SB
#undef PG8_STAGE
#undef PG8_LDA
#undef PG8_LDB
#undef PG8_MMA
#undef PG8_WAIT_V
#undef PG8_WAIT_L
#undef PG8_BAR
#undef PG8_SCHED
}
}

namespace att {
using bf16 = __hip_bfloat16;
typedef short bf16x8 __attribute__((ext_vector_type(8)));
typedef short s16x4 __attribute__((ext_vector_type(4)));
typedef float f32x16 __attribute__((ext_vector_type(16)));
typedef float f32x4 __attribute__((ext_vector_type(4)));
typedef unsigned u32x4 __attribute__((ext_vector_type(4)));
typedef unsigned u32x2 __attribute__((ext_vector_type(2)));
constexpr int D = 128, LD = 1024, SEQ = 4096, NH = 8, NB = 8;
constexpr float SCALE = 0.08838834764831845f;
constexpr float THR = 8.f;
constexpr int NW = 8, QBLK = 32, KVBLK = 64, QB = NW * QBLK;
constexpr int SHM_V = KVBLK * D * 2, SHM_K = KVBLK * D * 2;
constexpr int LDS_BYTES = 2 * SHM_V + 2 * SHM_K + NW * 64 * 4;

#define KSWZ(row, colB) ((row) * 256 + ((colB) ^ (((row) & 7) << 4)))
#define SBAR() __builtin_amdgcn_sched_barrier(0)
__device__ __forceinline__ int v_st(int k, int c) { const int kk = (k & ~0xC) | ((k & 4) << 1) | ((k & 8) >> 1); return ((kk >> 3) * 4 + (c >> 5)) * 512 + ((kk & 7) * 32 + (c & 31)) * 2; }
__device__ __forceinline__ int v_rd_base(int lane) { return ((lane & 3) << 3) | (((lane >> 2) & 3) << 6) | (((lane >> 4) & 1) << 5) | (((lane >> 5) & 1) << 8); }
constexpr int v_rd_off(int d0, int ks, int half) { return d0 * 512 + ks * 4096 + half * 2048; }
__device__ __forceinline__ int crow(int r, int hi) { return (r & 3) + 8 * (r >> 2) + 4 * hi; }
__device__ __forceinline__ unsigned cvtpk(float lo, float hi) { unsigned r; asm volatile("v_cvt_pk_bf16_f32 %0, %1, %2" : "=v"(r) : "v"(lo), "v"(hi)); return r; }
__device__ __forceinline__ bf16x8 load8(const bf16* p) { return *reinterpret_cast<const bf16x8*>(p); }

__device__ __forceinline__ void sel_mask_tile(f32x16& p0, f32x16& p1, unsigned wlo, unsigned whi, int hi) {
    const unsigned NEGB = 0xff800000u;
    const unsigned lo = wlo >> (4 * hi), h2 = whi >> (4 * hi);
#pragma unroll
    for (int r = 0; r < 16; ++r) {
        const int c = (r & 3) + 8 * (r >> 2);
        const unsigned m0 = (unsigned)__builtin_amdgcn_sbfe((int)lo, c, 1), m1 = (unsigned)__builtin_amdgcn_sbfe((int)h2, c, 1);
        p0[r] = __uint_as_float((__float_as_uint(p0[r]) & m0) | (NEGB & ~m0));
        p1[r] = __uint_as_float((__float_as_uint(p1[r]) & m1) | (NEGB & ~m1));
    }
}
__device__ __forceinline__ void partialSM(f32x16& p0, f32x16& p1, float& m_reg, float& mn, float& alpha) {
    float pmax = p0[0];
#pragma unroll
    for (int r = 1; r < 16; ++r) pmax = fmaxf(pmax, p0[r]);
#pragma unroll
    for (int r = 0; r < 16; ++r) pmax = fmaxf(pmax, p1[r]);
    { auto rr = __builtin_amdgcn_permlane32_swap(__float_as_uint(pmax), __float_as_uint(pmax), false, false);
      pmax = fmaxf(__uint_as_float(rr[0]), __uint_as_float(rr[1])); }
    constexpr float C2 = 1.4426950408889634f * SCALE;
    if (__builtin_expect(__all((pmax - m_reg) * SCALE <= THR), 1)) { mn = m_reg; alpha = 1.f; }
    else { mn = fmaxf(m_reg, pmax); alpha = __builtin_amdgcn_exp2f((m_reg - mn) * C2); m_reg = mn; }
    const float mnL = -mn * C2;
#pragma unroll
    for (int r = 0; r < 16; ++r) p0[r] = fmaf(p0[r], C2, mnL);
#pragma unroll
    for (int r = 0; r < 16; ++r) p1[r] = fmaf(p1[r], C2, mnL);
#pragma unroll
    for (int r = 0; r < 16; ++r) p0[r] = __builtin_amdgcn_exp2f(p0[r]);
}
__device__ __forceinline__ void finishSM(f32x16& p0, f32x16& p1, float alpha, float& l_reg, bf16x8& pa0, bf16x8& pa1, bf16x8& pa2, bf16x8& pa3) {
#pragma unroll
    for (int r = 0; r < 16; ++r) p1[r] = __builtin_amdgcn_exp2f(p1[r]);
    float ps = 0;
#pragma unroll
    for (int r = 0; r < 16; ++r) ps += p0[r];
#pragma unroll
    for (int r = 0; r < 16; ++r) ps += p1[r];
    { auto rr = __builtin_amdgcn_permlane32_swap(__float_as_uint(ps), __float_as_uint(ps), false, false);
      ps = __uint_as_float(rr[0]) + __uint_as_float(rr[1]); }
    l_reg = l_reg * alpha + ps;
#define PK4(P, B_, OUT) do { unsigned a0 = cvtpk(P[B_+0], P[B_+1]), a1 = cvtpk(P[B_+2], P[B_+3]);                          \
        unsigned b0 = cvtpk(P[B_+4], P[B_+5]), b1 = cvtpk(P[B_+6], P[B_+7]);                                             \
        auto r0 = __builtin_amdgcn_permlane32_swap(a0, b0, false, false); auto r1 = __builtin_amdgcn_permlane32_swap(a1, b1, false, false); \
        u32x4 w = {r0[0], r1[0], r0[1], r1[1]}; OUT = *reinterpret_cast<bf16x8*>(&w); } while (0)
    PK4(p0, 0, pa0); PK4(p0, 8, pa1); PK4(p1, 0, pa2); PK4(p1, 8, pa3);
#undef PK4
}
template <int KB>
__device__ __forceinline__ void qkt(f32x16& p0, f32x16& p1, const char* K_lds, int r32, int hi, const bf16x8* qr) {
    p0 = f32x16{}; p1 = f32x16{};
    const char* kb[4];
#pragma unroll
    for (int dd = 0; dd < 4; ++dd) kb[dd] = K_lds + KB * SHM_K + KSWZ(r32, (dd * 16 + hi * 8) * 2);
#pragma unroll
    for (int d0 = 0; d0 < 8; ++d0) { const char* a = kb[d0 & 3] + (d0 >> 2) * 128;
        bf16x8 b0 = *reinterpret_cast<const bf16x8*>(a);
        bf16x8 b1 = *reinterpret_cast<const bf16x8*>(a + 32 * 256);
        p0 = __builtin_amdgcn_mfma_f32_32x32x16_bf16(b0, qr[d0], p0, 0, 0, 0);
        p1 = __builtin_amdgcn_mfma_f32_32x32x16_bf16(b1, qr[d0], p1, 0, 0, 0); }
}
template <int VB>
__device__ __forceinline__ void pv_tile(f32x16* o, int vb0, bf16x8 pa0, bf16x8 pa1, bf16x8 pa2, bf16x8 pa3) {
#define TRRD(dst, off) asm volatile("ds_read_b64_tr_b16 %0, %1 offset:%2" : "=&v"(dst) : "v"(vb0), "i"(off) : "memory")
#define PV_D0(d0) do { s16x4 l0, l1, l2, l3, h0, h1, h2, h3; constexpr int b_ = VB * SHM_V + v_rd_off(d0, 0, 0); \
        TRRD(l0, b_); TRRD(h0, b_ + 2048); TRRD(l1, b_ + 4096); TRRD(h1, b_ + 6144); TRRD(l2, b_ + 8192); TRRD(h2, b_ + 10240); TRRD(l3, b_ + 12288); TRRD(h3, b_ + 14336); \
        asm volatile("s_waitcnt lgkmcnt(0)" ::: "memory"); SBAR();   \
        o[d0] = __builtin_amdgcn_mfma_f32_32x32x16_bf16(pa0, (bf16x8){l0[0], l0[1], l0[2], l0[3], h0[0], h0[1], h0[2], h0[3]}, o[d0], 0, 0, 0);   \
        o[d0] = __builtin_amdgcn_mfma_f32_32x32x16_bf16(pa1, (bf16x8){l1[0], l1[1], l1[2], l1[3], h1[0], h1[1], h1[2], h1[3]}, o[d0], 0, 0, 0);   \
        o[d0] = __builtin_amdgcn_mfma_f32_32x32x16_bf16(pa2, (bf16x8){l2[0], l2[1], l2[2], l2[3], h2[0], h2[1], h2[2], h2[3]}, o[d0], 0, 0, 0);   \
        o[d0] = __builtin_amdgcn_mfma_f32_32x32x16_bf16(pa3, (bf16x8){l3[0], l3[1], l3[2], l3[3], h3[0], h3[1], h3[2], h3[3]}, o[d0], 0, 0, 0); } while (0)
    PV_D0(0); PV_D0(1); PV_D0(2); PV_D0(3);
#undef PV_D0
#undef TRRD
}

struct BlockRef { const bf16* Q; const bf16* K; const bf16* V; bf16* O; const unsigned long long* MW; int P0; };
struct Seam { bf16x8 qr[8]; bf16x8 st_v0, st_v1, st_k0, st_k1; };
#define ROW(p, k0, rr) ((p) + (size_t)((k0) + (rr)) * LD + sc)
#define VMW() asm volatile("s_waitcnt vmcnt(0)" ::: "memory")
#define VMWN(n) asm volatile("s_waitcnt vmcnt(%0)" :: "i"(n) : "memory")
#define SLOAD_H(Kp, Vp, k0) do { S.st_v0 = load8(ROW(Vp, k0, sr)); S.st_v1 = load8(ROW(Vp, k0, 32 + sr));              \
                         S.st_k0 = load8(ROW(Kp, k0, sr)); S.st_k1 = load8(ROW(Kp, k0, 32 + sr)); } while (0)
#define SWRITE_HK(bf) do { *(bf16x8*)(K_lds + (bf) * SHM_K + kws) = S.st_k0; *(bf16x8*)(K_lds + (bf) * SHM_K + kws + 32 * 256) = S.st_k1; } while (0)
#define SWRITE_HV(bf) do { *(bf16x8*)(V_lds + (bf) * SHM_V + vst0) = S.st_v0; *(bf16x8*)(V_lds + (bf) * SHM_V + vst1) = S.st_v1; } while (0)
#define SWRITE_H(bf) do { SWRITE_HV(bf); SWRITE_HK(bf); } while (0)
__device__ __forceinline__ void attn_prime(const BlockRef& cur, char* lds, Seam& S) {
    const int tid = threadIdx.x, wid = __builtin_amdgcn_readfirstlane(tid >> 6), lane = tid & 63, r32 = lane & 31, hi = lane >> 5;
    const int sr = tid >> 4, sc = (tid & 15) * 8, kws = KSWZ(sr, sc * 2); char* K_lds = lds + 2 * SHM_V;
#pragma unroll
    for (int d0 = 0; d0 < 8; ++d0) S.qr[d0] = load8(cur.Q + (size_t)(wid * QBLK + r32) * LD + d0 * 16 + hi * 8);
    SLOAD_H(cur.K, cur.V, 0); VMW(); SWRITE_HK(0);
    __syncthreads();
}
__device__ __forceinline__ void attn_block(const BlockRef& cur, const BlockRef& nxt, char* lds, Seam& S) {
    const int tid = threadIdx.x, wid = __builtin_amdgcn_readfirstlane(tid >> 6), lane = tid & 63, r32 = lane & 31, hi = lane >> 5;
    const int NT = (cur.P0 + QB - 1) / KVBLK + 1;
    char* V_lds = lds; char* K_lds = lds + 2 * SHM_V;
    float* ws = (float*)(lds + 2 * SHM_V + 2 * SHM_K) + wid * 64; float* li_l = ws, * al_l = ws + 32;
    float m_reg = -1e30f, l_reg = 0; f32x16 o[4] = {};
    const int sr = tid >> 4, sc = (tid & 15) * 8, vst0 = v_st(sr, sc), vst1 = v_st(32 + sr, sc), kws = KSWZ(sr, sc * 2);
    const int vb0 = (int)(uintptr_t)V_lds + v_rd_base(lane);
    const bf16* Kh = cur.K; const bf16* Vh = cur.V;
    const unsigned mrow_off = (unsigned)(wid * QBLK + r32) * 512u;
    u32x2 mw;
#define LDMASK(t) (*(const u32x2*)((const char*)cur.MW + (mrow_off + (unsigned)(t) * 8u)))
#define RESC(a) do { if (__any((a) < 1.f)) { if (hi == 0) al_l[r32] = (a); asm volatile("s_waitcnt lgkmcnt(0)" ::: "memory");              \
                     for (int d_ = 0; d_ < 4; ++d_) for (int r = 0; r < 16; ++r) o[d_][r] *= al_l[crow(r, hi)]; } } while (0)
#define KBASE(t) ((t) * KVBLK)
#define MASKT(P0_, P1_) sel_mask_tile(P0_, P1_, mw.x, mw.y, hi)
    constexpr int NQL = 8;
#define SEAM_K0() do { VMWN(NQL); SWRITE_HK(0); SBAR(); } while (0)
    f32x16 pA0, pA1, pB0, pB1; float mnA, mnB, alA, alB; bf16x8 pa0, pa1, pa2, pa3;
    SWRITE_HV(0); SBAR();
    mw = LDMASK(0);
    if (NT > 1) { SLOAD_H(Kh, Vh, KBASE(1)); }
    SBAR(); qkt<0>(pA0, pA1, K_lds, r32, hi, S.qr);
    MASKT(pA0, pA1); partialSM(pA0, pA1, m_reg, mnA, alA);
    if (NT > 1) { VMW(); SWRITE_H(1); }
    __syncthreads();
#define HALF_STEP(PX0, PX1, mnX, alX, PY0, PY1, alY, t, KB, VB, SB) do {                                                      \
        SBAR(); qkt<KB>(PX0, PX1, K_lds, r32, hi, S.qr);                                                                      \
        finishSM(PY0, PY1, alY, l_reg, pa0, pa1, pa2, pa3); SBAR();                                                           \
        if ((t) + 1 < NT) { SLOAD_H(Kh, Vh, KBASE((t) + 1)); SBAR(); }                                                        \
        mw = LDMASK(t); SBAR();                                                                                               \
        pv_tile<VB>(o, vb0, pa0, pa1, pa2, pa3); MASKT(PX0, PX1); partialSM(PX0, PX1, m_reg, mnX, alX);                       \
        __syncthreads();                                                                                                      \
        if ((t) + 1 < NT) { VMW(); SWRITE_H(SB); }                                                                            \
        RESC(alX); __syncthreads(); } while (0)
    for (int t = 1; t + 1 < NT; t += 2) {
        HALF_STEP(pB0, pB1, mnB, alB, pA0, pA1, alA, t, 1, 0, 0);
        HALF_STEP(pA0, pA1, mnA, alA, pB0, pB1, alB, t + 1, 0, 1, 1);
    }
    mw = LDMASK(NT - 1);
    SBAR(); qkt<1>(pB0, pB1, K_lds, r32, hi, S.qr); SBAR();
    SLOAD_H(nxt.K, nxt.V, 0); SBAR();
#pragma unroll
    for (int d0 = 0; d0 < 8; ++d0) S.qr[d0] = load8(nxt.Q + (size_t)(wid * QBLK + r32) * LD + d0 * 16 + hi * 8);
    SBAR();
    finishSM(pA0, pA1, alA, l_reg, pa0, pa1, pa2, pa3); SBAR();
    pv_tile<0>(o, vb0, pa0, pa1, pa2, pa3);
    MASKT(pB0, pB1); partialSM(pB0, pB1, m_reg, mnB, alB); __syncthreads(); RESC(alB);
    finishSM(pB0, pB1, alB, l_reg, pa0, pa1, pa2, pa3); SBAR(); pv_tile<1>(o, vb0, pa0, pa1, pa2, pa3);
    SBAR(); SEAM_K0();
    if (hi == 0) li_l[r32] = l_reg; asm volatile("s_waitcnt lgkmcnt(0)" ::: "memory");
    float rli[16];
#pragma unroll
    for (int r = 0; r < 16; ++r) rli[r] = __builtin_amdgcn_rcpf(li_l[crow(r, hi)]);
    bf16* Ow = cur.O + (size_t)(wid * QBLK) * LD;
#pragma unroll
    for (int r = 0; r < 16; ++r) { const int orow = crow(r, hi);
#pragma unroll
        for (int d0 = 0; d0 < 4; ++d0) { const float v = o[d0][r] * rli[r];
            const float vn = __shfl_xor(v, 1);
            if ((r32 & 1) == 0) *(unsigned*)(Ow + (size_t)orow * LD + d0 * 32 + r32) = cvtpk(v, vn); } }
    __syncthreads();
#undef RESC
#undef KBASE
#undef MASKT
#undef SEAM_K0
#undef LDMASK
#undef HALF_STEP
}
#undef ROW
#undef VMW
#undef VMWN
#undef SLOAD_H
#undef SWRITE_HK
#undef SWRITE_HV
#undef SWRITE_H

struct Item { int bh, qb0, qb1; };
__device__ __forceinline__ Item decode(int L) { L &= 511; Item it; const int xcd = L & 7, k = L >> 3, gi = k >> 3, r = k & 7; it.bh = gi * 8 + xcd; it.qb0 = r; it.qb1 = 15 - r; return it; }
__device__ __forceinline__ BlockRef mkref(const Item& it, int pass, const bf16* Q, const bf16* K, const bf16* V, bf16* O, const unsigned long long* MW) {
    const int qb = pass ? it.qb1 : it.qb0, b = it.bh >> 3, h = it.bh & 7;
    BlockRef r; const size_t row0 = (size_t)b * SEQ + (size_t)qb * QB;
    r.Q = Q + row0 * LD + h * D; r.O = O + row0 * LD + h * D; r.K = K + (size_t)b * SEQ * LD + h * D; r.V = V + (size_t)b * SEQ * LD + h * D;
    r.MW = MW + row0 * 64; r.P0 = qb * QB; return r;
}
__device__ __forceinline__ void attn_phase(char* lds, const bf16* Q, const bf16* K, const bf16* V, bf16* O, const unsigned long long* MW, int first, int stride) {
    constexpr int total = (DUP_PHASE == 5) ? 1024 : 512;
    int L = first; if (L >= total) return;
    Item it = decode(L); int pass = 0;
    BlockRef cur = mkref(it, 0, Q, K, V, O, MW);
    Seam S;
    attn_prime(cur, lds, S);
    for (;;) {
        const bool more_pass = pass == 0, more_item = L + stride < total, last = !more_pass && !more_item;
        Item itn = it; int passn = pass + 1, Ln = L;
        if (!more_pass) { passn = 0; Ln = more_item ? L + stride : L; itn = decode(Ln); }
        const BlockRef nxt = last ? cur : mkref(itn, passn, Q, K, V, O, MW);
        attn_block(cur, nxt, lds, S);
        if (last) break;
        cur = nxt; it = itn; pass = passn; L = Ln;
    }
}
#undef KSWZ
#undef SBAR
}

constexpr int NWAVES = 8;
constexpr int BATCH = 8, SEQ = 4096, DM = 1024, FF = 4096, TOK = BATCH * SEQ;
constexpr int NWIN = 7936;
constexpr float LN_EPS = 1e-5f;
constexpr float ALPHA = 1.189207115002721f;
constexpr float IDX_SCALE = 0.04419417382415922f;
enum { K_GELU = 0, K_GELUT = 1, K_Q = 2, K_K = 3, K_V = 4, K_SGA = 5, K_SGB = 6, K_QI = 7, K_KIW = 8 };

constexpr size_t MiB = 1u << 20;
constexpr size_t WS_CTL = 0, CTL_ZERO_BYTES = 1 * MiB;
constexpr size_t WS_WIN = 2 * MiB;
constexpr size_t WS_WA = 18 * MiB, WS_WB = 20 * MiB, WS_WO = 22 * MiB, WS_WUP = 24 * MiB, WS_WDN = 32 * MiB;
constexpr size_t WS_WSGU = 40 * MiB;
constexpr size_t WS_KI = 41 * MiB;
constexpr size_t WS_WI = 45 * MiB;
constexpr size_t WS_MASK = 46 * MiB;
constexpr size_t SLOT = 64 * MiB;
constexpr size_t WS_S0 = 1 * SLOT, WS_S1 = 2 * SLOT, WS_S2 = 3 * SLOT, WS_S3 = 4 * SLOT, WS_S4 = 5 * SLOT, WS_S5 = 6 * SLOT, WS_S6 = 7 * SLOT, WS_END = 8 * SLOT;
constexpr size_t SCORE_BATCH_ELEMS = 64ull * 65 * 2048;
constexpr int CW_BAR = 4096;

constexpr int RING_OFF = 0, RING_BYTES = 131072;
constexpr int LDSCTL_OFF = RING_BYTES, MISC_OFF = LDSCTL_OFF + 320;
constexpr int LDS_BYTES = 147456;
static_assert(MISC_OFF + 128 <= LDS_BYTES, "LDS map");

#define GAS __attribute__((address_space(1)))
#define LAS __attribute__((address_space(3)))
typedef unsigned short bf16;
typedef unsigned v4u __attribute__((ext_vector_type(4)));
typedef unsigned v2u __attribute__((ext_vector_type(2)));
typedef float f32x4 __attribute__((ext_vector_type(4)));
typedef short bf16x8 __attribute__((ext_vector_type(8)));
#define LDS_WAIT() asm volatile("s_waitcnt lgkmcnt(0)" ::: "memory")
#define VM_WAIT() asm volatile("s_waitcnt vmcnt(0)" ::: "memory")
__device__ __forceinline__ unsigned pk2(float lo, float hi) { return pg8::cvt_pk_bf16(lo, hi); }
__device__ __forceinline__ float bf2f(unsigned short h) { return __uint_as_float((unsigned)h << 16); }

#define XB_TMO      128
#define XB_XCNT(j)  (256  + 64 * (j))
#define XB_XSUB(j)  (1280 + 64 * (j))
#define XB_XGEN(j)  (2304 + 64 * (j))
#define XB_TOP      3328
#define XB_TOPGEN   3392
#define XCD_BAR_WORDS 3456
#define XB_SPIN_CAP (1u << 20)
__device__ __forceinline__ unsigned xb_ld(unsigned* p)              { return __hip_atomic_load(p, __ATOMIC_RELAXED, __HIP_MEMORY_SCOPE_AGENT); }
__device__ __forceinline__ unsigned xb_add(unsigned* p, unsigned v) { return __hip_atomic_fetch_add(p, v, __ATOMIC_RELAXED, __HIP_MEMORY_SCOPE_AGENT); }
__device__ __forceinline__ unsigned xb_xcc_id() { return (unsigned)__builtin_amdgcn_s_getreg((3 << 11) | 20) & 0xFu; }
#define XB_SPIN(cond, bar) do { unsigned _sp = 0; while (cond) { __builtin_amdgcn_s_sleep(1); \
    if ((++_sp & 255u) == 0u) { if (xb_ld(&(bar)[XB_TMO])) break; if (_sp > XB_SPIN_CAP) { atomicAdd(&(bar)[XB_TMO], 1u); break; } } } } while (0)
struct XcdBarrier { unsigned* bar; unsigned x; volatile LAS unsigned* st; };
__device__ __forceinline__ XcdBarrier xcd_barrier_post(unsigned* bar, volatile LAS unsigned* st) {
    XcdBarrier b; b.bar = bar; b.x = xb_xcc_id(); b.st = st;
    if (threadIdx.x == 0) (void)xb_add(&bar[XB_XCNT(b.x)], 1u);
    return b;
}
__device__ __forceinline__ void xcd_barrier_complete(unsigned* bar, unsigned x, unsigned& nloc, unsigned& nx) {
    const unsigned G = gridDim.x * gridDim.y * gridDim.z;
    unsigned sum, cnt, mine, sp = 0u;
    for (;;) {
        sum = 0u; cnt = 0u; mine = 0u;
#pragma unroll
        for (unsigned j = 0; j < 16; ++j) { const unsigned c = xb_ld(&bar[XB_XCNT(j)]); sum += c; cnt += (c > 0u) ? 1u : 0u; mine = (j == x) ? c : mine; }
        if (sum == G) break;
        __builtin_amdgcn_s_sleep(1);
        if ((++sp & 255u) == 0u) { if (xb_ld(&bar[XB_TMO])) break; if (sp > XB_SPIN_CAP) { atomicAdd(&bar[XB_TMO], 1u); break; } }
    }
    nloc = mine > 0u ? mine : 1u; nx = cnt > 0u ? cnt : 1u;
}
__device__ __forceinline__ void xcd_barrier(const XcdBarrier& b) {
    asm volatile("s_waitcnt vmcnt(0)" ::: "memory");
    __syncthreads();
    if (threadIdx.x == 0) {
        unsigned* bar = b.bar;
        __builtin_amdgcn_s_waitcnt(0);
        unsigned nloc = b.st[0], nx = b.st[1];
        if (nloc == 0u) { xcd_barrier_complete(bar, b.x, nloc, nx); b.st[0] = nloc; b.st[1] = nx; }
        const unsigned old = xb_add(&bar[XB_XSUB(b.x)], 1u);
        const unsigned gen = old / nloc;
        if (old + 1u == (gen + 1u) * nloc) {
            __builtin_amdgcn_fence(__ATOMIC_RELEASE, "agent");
            asm volatile("s_waitcnt vmcnt(0)" ::: "memory");
            const unsigned og = xb_add(&bar[XB_TOP], 1u);
            const unsigned tg = og / nx;
            if (og + 1u == (tg + 1u) * nx) xb_add(&bar[XB_TOPGEN], 1u);
            else XB_SPIN(xb_ld(&bar[XB_TOPGEN]) == tg, bar);
            __builtin_amdgcn_fence(__ATOMIC_ACQUIRE, "agent");
            xb_add(&bar[XB_XGEN(b.x)], 1u);
            asm volatile("s_waitcnt vmcnt(0)" ::: "memory");
        } else {
            XB_SPIN(xb_ld(&bar[XB_XGEN(b.x)]) == gen, bar);
            __builtin_amdgcn_fence(__ATOMIC_ACQUIRE, "agent");
            asm volatile("s_waitcnt vmcnt(0)" ::: "memory");
        }
    }
    __syncthreads();
}

__device__ __forceinline__ float wave_sum(float v) {
#pragma unroll
    for (int o = 1; o < 64; o <<= 1) v += __shfl_xor(v, o);
    return v;
}

struct Args {
    const float* in[15];
    float* out; unsigned char* ws; int ph_lo, ph_hi;
};

__device__ __forceinline__ int win_srccol(int r) { return r < 5120 ? r : (r < 7168 ? r - 5120 + 5704 : (r < 7752 ? r - 7168 + 5120 : -1)); }
template <bool WIN>
__device__ __forceinline__ void p0_transpose_item(const float* W, int K, int ldw, bf16* WT, int nblk, LAS float* scr, int item, int lane) {
    const int kb = item / nblk, nb = item % nblk, k0 = 64 * kb, n0 = 32 * nb;
    const int n = n0 + (lane & 31); const int col = WIN ? win_srccol(n) : n;
#pragma unroll 8
    for (int i = 0; i < 32; ++i) { const int kk = 2 * i + (lane >> 5); scr[kk * 33 + (lane & 31)] = (col >= 0) ? W[(size_t)(k0 + kk) * ldw + col] : 0.f; }
    LDS_WAIT(); asm volatile("" ::: "memory");
    const int c = lane & 7;
#pragma unroll
    for (int j = 0; j < 4; ++j) { const int nn = (lane >> 3) + 8 * j; const LAS float* s = scr + (8 * c) * 33 + nn;
        v4u o; o.x = pk2(s[0 * 33], s[1 * 33]); o.y = pk2(s[2 * 33], s[3 * 33]); o.z = pk2(s[4 * 33], s[5 * 33]); o.w = pk2(s[6 * 33], s[7 * 33]);
        *(GAS v4u*)(WT + (size_t)(n0 + nn) * K + k0 + 8 * c) = o; }
    LDS_WAIT(); asm volatile("" ::: "memory");
}
__device__ __forceinline__ void p0_prologue(const Args& a, LAS unsigned char* lds, int gw, int NGW, int wave, int lane) {
    unsigned char* ws = a.ws;
    LAS float* scr = (LAS float*)(lds + RING_OFF + wave * 16384);
    constexpr int I_WIN = (DM / 64) * (NWIN / 32), I_SQ = (DM / 64) * (DM / 32), I_UP = (DM / 64) * (FF / 32), I_DN = (FF / 64) * (DM / 32);
    constexpr int NITEMS = I_WIN + 3 * I_SQ + I_UP + I_DN;
    for (int it = gw; it < NITEMS; it += NGW) {
        int r = it;
        if (r < I_WIN) { p0_transpose_item<true>(a.in[1], DM, 7752, (bf16*)(ws + WS_WIN), NWIN / 32, scr, r, lane); continue; } r -= I_WIN;
        if (r < I_SQ) { p0_transpose_item<false>(a.in[6], DM, DM, (bf16*)(ws + WS_WA), DM / 32, scr, r, lane); continue; } r -= I_SQ;
        if (r < I_SQ) { p0_transpose_item<false>(a.in[7], DM, DM, (bf16*)(ws + WS_WB), DM / 32, scr, r, lane); continue; } r -= I_SQ;
        if (r < I_SQ) { p0_transpose_item<false>(a.in[8], DM, DM, (bf16*)(ws + WS_WO), DM / 32, scr, r, lane); continue; } r -= I_SQ;
        if (r < I_UP) { p0_transpose_item<false>(a.in[11], DM, FF, (bf16*)(ws + WS_WUP), FF / 32, scr, r, lane); continue; } r -= I_UP;
        p0_transpose_item<false>(a.in[12], FF, DM, (bf16*)(ws + WS_WDN), DM / 32, scr, r, lane);
    }
    { const float* w = a.in[4]; bf16* o = (bf16*)(ws + WS_WSGU);
      for (int i = gw * 64 + lane; i < 8 * 128 * 128; i += NGW * 64) { const int s = i & 127, t = (i >> 7) & 127; o[i] = (bf16)(pk2(s <= t ? w[i] : 0.f, 0.f) & 0xffffu); } }
    { const f32x4* x = (const f32x4*)a.in[0]; v4u* xb = (v4u*)(ws + WS_S0); const int n8 = TOK * DM / 8, step = NGW * 64;
      for (int i = gw * 64 + lane; i < n8; i += 4 * step) {
          f32x4 v[8];
#pragma unroll
          for (int u = 0; u < 4; ++u) { const int ii = i + u * step; const int jj = ii < n8 ? ii : i; v[2 * u] = x[2 * jj]; v[2 * u + 1] = x[2 * jj + 1]; }
#pragma unroll
          for (int u = 0; u < 4; ++u) { const int ii = i + u * step; if (ii < n8) { v4u o; o.x = pk2(v[2 * u].x, v[2 * u].y); o.y = pk2(v[2 * u].z, v[2 * u].w); o.z = pk2(v[2 * u + 1].x, v[2 * u + 1].y); o.w = pk2(v[2 * u + 1].z, v[2 * u + 1].w); xb[ii] = o; } } } }
}

struct InProjSched : pg8::StaticOrder {
    const char* X; const char* W; int mode;
    static constexpr size_t tstep = (size_t)256 * DM * 2;
    __device__ __forceinline__ bool next(int i, pg8::Unit& u) const {
        int pm, j; if (!next_mn(i, pm, j)) return false;
        int tile; if (mode == 1) tile = j < 8 ? j : (j < 12 ? j + 12 : j + 16); else tile = j < 12 ? j + 8 : j + 12;
        u.pm = pm; u.pn = tile;
        u.kind = tile < 4 ? K_GELU : tile < 8 ? K_GELUT : tile < 12 ? K_Q : tile < 16 ? K_K : tile < 20 ? K_V : tile < 24 ? K_SGA : tile < 28 ? K_SGB : tile < 30 ? K_QI : K_KIW;
        return true;
    }
    __device__ __forceinline__ const char* aptr(const pg8::Unit& u) const { return u.kind == K_GELUT ? W + (size_t)u.pn * tstep : X + (size_t)u.pm * tstep; }
    __device__ __forceinline__ const char* bptr(const pg8::Unit& u) const { return u.kind == K_GELUT ? X + (size_t)u.pm * tstep : W + (size_t)u.pn * tstep; }
};
template <int ACT>
__device__ __forceinline__ void store_tile_bf16(const pg8::f32x4 (&acc)[2][2][4][2], bf16* O, size_t ld, size_t row0, size_t col0, int wr, int wc, int fr, int fq, size_t bjstride = 128) {
    bf16* base = O + (row0 + wr * 64 + fr) * ld + col0 + wc * 32 + 8 * fq;
#pragma unroll
    for (int ai = 0; ai < 2; ++ai)
#pragma unroll
        for (int m = 0; m < 4; ++m) { bf16* rowp = base + (size_t)(ai * 128 + m * 16) * ld;
#pragma unroll
            for (int bj = 0; bj < 2; ++bj) { pg8::f32x4 v0 = acc[ai][bj][m][0], v1 = acc[ai][bj][m][1];
#pragma unroll
                for (int e = 0; e < 4; ++e) {
                    if (ACT == 1) { v0[e] = pg8::gelu_tanh(v0[e]); v1[e] = pg8::gelu_tanh(v1[e]); }
                    if (ACT == 2) { v0[e] = pg8::sigmoidf_(v0[e]); v1[e] = pg8::sigmoidf_(v1[e]); }
                    if (ACT == 3) { const float a0 = fmaxf(v0[e], 0.f), a1 = fmaxf(v1[e], 0.f); v0[e] = a0 * a0; v1[e] = a1 * a1; } }
                v4u w; w.x = pk2(v0[0], v0[1]); w.y = pk2(v0[2], v0[3]); w.z = pk2(v1[0], v1[1]); w.w = pk2(v1[2], v1[3]);
                *(v4u*)(rowp + bj * bjstride) = w; } }
}
struct EpiInProj {
    static constexpr bool PERM = true, TOUCH = false;
    __device__ __forceinline__ void touch(const pg8::Unit&, int, unsigned&) const {}
    unsigned char* ws;
    __device__ __forceinline__ void operator()(const pg8::f32x4 (&acc)[2][2][4][2], const pg8::Unit& u, int wr, int wc, int fr, int fq) const {
        const size_t tok0 = (size_t)u.pm * 256; const int tile = u.pn;
        switch (u.kind) {
        case K_GELU:  store_tile_bf16<1>(acc, (bf16*)(ws + WS_S1), DM, tok0, (size_t)tile * 256, wr, wc, fr, fq); break;
        case K_GELUT: store_tile_bf16<1>(acc, (bf16*)(ws + WS_S2) + (size_t)u.pm * 2 * 1024 * 128, 128, (size_t)(tile - 4) * 256, 0, wr, wc, fr, fq, (size_t)1024 * 128); break;
        case K_Q:     store_tile_bf16<0>(acc, (bf16*)(ws + WS_S2), DM, tok0, (size_t)(tile - 8) * 256, wr, wc, fr, fq); break;
        case K_K:     store_tile_bf16<0>(acc, (bf16*)(ws + WS_S3), DM, tok0, (size_t)(tile - 12) * 256, wr, wc, fr, fq); break;
        case K_V:     store_tile_bf16<0>(acc, (bf16*)(ws + WS_S4), DM, tok0, (size_t)(tile - 16) * 256, wr, wc, fr, fq); break;
        case K_SGA:   store_tile_bf16<2>(acc, (bf16*)(ws + WS_S3), DM, tok0, (size_t)(tile - 20) * 256, wr, wc, fr, fq); break;
        case K_SGB:   store_tile_bf16<2>(acc, (bf16*)(ws + WS_S5), DM, tok0, (size_t)(tile - 24) * 256, wr, wc, fr, fq); break;
        case K_QI:    store_tile_bf16<0>(acc, (bf16*)(ws + WS_S4), 512, tok0, (size_t)(tile - 28) * 256, wr, wc, fr, fq); break;
        default: {
            bf16* KI = (bf16*)(ws + WS_KI); float* WI = (float*)(ws + WS_WI);
#pragma unroll
            for (int ai = 0; ai < 2; ++ai)
#pragma unroll
                for (int m = 0; m < 4; ++m) { const size_t tok = tok0 + ai * 128 + wr * 64 + m * 16 + fr; const pg8::f32x4 v0 = acc[ai][0][m][0], v1 = acc[ai][0][m][1];
                    if (wc < 2) { v4u w; w.x = pk2(v0[0], v0[1]); w.y = pk2(v0[2], v0[3]); w.z = pk2(v1[0], v1[1]); w.w = pk2(v1[2], v1[3]); *(v4u*)(KI + tok * 64 + wc * 32 + 8 * fq) = w; }
                    else if (wc == 2 && fq == 0) { *(pg8::f32x4*)(WI + tok * 8) = v0 * IDX_SCALE; *(pg8::f32x4*)(WI + tok * 8 + 4) = v1 * IDX_SCALE; } }
        } }
    }
};
__device__ __forceinline__ void touch_line(unsigned& d, const void* p) { asm volatile("global_load_dword %0, %1, off" : "+v"(d) : "v"(p) : "memory"); }
struct EpiGate1 {
    static constexpr bool PERM = true, TOUCH = true;
    const bf16* G; bf16* O;
    __device__ __forceinline__ void touch(const pg8::Unit& u, int tid, unsigned& d) const {
        const bf16* p = G + ((size_t)u.pm * 256 + (tid >> 1)) * DM + (size_t)u.pn * 256 + (tid & 1) * 128;
        touch_line(d, p); touch_line(d, p + 64);
    }
    __device__ __forceinline__ void operator()(const pg8::f32x4 (&acc)[2][2][4][2], const pg8::Unit& u, int wr, int wc, int fr, int fq) const {
        const size_t off0 = ((size_t)u.pm * 256 + wr * 64 + fr) * DM + (size_t)u.pn * 256 + wc * 32 + 8 * fq;
#pragma unroll
        for (int ai = 0; ai < 2; ++ai) {
            v4u g[4][2];
#pragma unroll
            for (int m = 0; m < 4; ++m)
#pragma unroll
                for (int bj = 0; bj < 2; ++bj) g[m][bj] = *(const v4u*)(G + off0 + (size_t)(ai * 128 + m * 16) * DM + bj * 128);
#pragma unroll
            for (int m = 0; m < 4; ++m)
#pragma unroll
                for (int bj = 0; bj < 2; ++bj) { const size_t off = off0 + (size_t)(ai * 128 + m * 16) * DM + bj * 128;
                    const v4u gg = g[m][bj]; const pg8::f32x4 v0 = acc[ai][bj][m][0], v1 = acc[ai][bj][m][1];
                    v4u w; w.x = pk2(v0[0] * pg8::bf_lo(gg.x), v0[1] * pg8::bf_hi(gg.x)); w.y = pk2(v0[2] * pg8::bf_lo(gg.y), v0[3] * pg8::bf_hi(gg.y));
                    w.z = pk2(v1[0] * pg8::bf_lo(gg.z), v1[1] * pg8::bf_hi(gg.z)); w.w = pk2(v1[2] * pg8::bf_lo(gg.w), v1[3] * pg8::bf_hi(gg.w));
                    *(v4u*)(O + off) = w; }
        }
    }
};
struct EpiGate2 {
    static constexpr bool PERM = true, TOUCH = true;
    const bf16* G; bf16* O;
    __device__ __forceinline__ void touch(const pg8::Unit& u, int tid, unsigned& d) const {
        const size_t o = ((size_t)u.pm * 256 + (tid >> 1)) * DM + (size_t)u.pn * 256 + (tid & 1) * 128;
        touch_line(d, G + o); touch_line(d, G + o + 64); touch_line(d, O + o); touch_line(d, O + o + 64);
    }
    __device__ __forceinline__ void operator()(const pg8::f32x4 (&acc)[2][2][4][2], const pg8::Unit& u, int wr, int wc, int fr, int fq) const {
        const size_t off0 = ((size_t)u.pm * 256 + wr * 64 + fr) * DM + (size_t)u.pn * 256 + wc * 32 + 8 * fq;
#pragma unroll
        for (int ab = 0; ab < 4; ++ab) { const int ai = ab >> 1, m0 = (ab & 1) * 2;
            v4u g[4][2], p[4][2];
#pragma unroll
            for (int m = m0; m < m0 + 2; ++m)
#pragma unroll
                for (int bj = 0; bj < 2; ++bj) { const size_t off = off0 + (size_t)(ai * 128 + m * 16) * DM + bj * 128; g[m][bj] = *(const v4u*)(G + off); p[m][bj] = *(const v4u*)(O + off); }
#pragma unroll
            for (int m = m0; m < m0 + 2; ++m)
#pragma unroll
                for (int bj = 0; bj < 2; ++bj) { const size_t off = off0 + (size_t)(ai * 128 + m * 16) * DM + bj * 128;
                    const v4u gg = g[m][bj], pp = p[m][bj]; const pg8::f32x4 v0 = acc[ai][bj][m][0], v1 = acc[ai][bj][m][1];
                    v4u w; w.x = pk2(fmaf(v0[0], pg8::bf_lo(gg.x), pg8::bf_lo(pp.x)), fmaf(v0[1], pg8::bf_hi(gg.x), pg8::bf_hi(pp.x)));
                    w.y = pk2(fmaf(v0[2], pg8::bf_lo(gg.y), pg8::bf_lo(pp.y)), fmaf(v0[3], pg8::bf_hi(gg.y), pg8::bf_hi(pp.y)));
                    w.z = pk2(fmaf(v1[0], pg8::bf_lo(gg.z), pg8::bf_lo(pp.z)), fmaf(v1[1], pg8::bf_hi(gg.z), pg8::bf_hi(pp.z)));
                    w.w = pk2(fmaf(v1[2], pg8::bf_lo(gg.w), pg8::bf_lo(pp.w)), fmaf(v1[3], pg8::bf_hi(gg.w), pg8::bf_hi(pp.w)));
                    *(v4u*)(O + off) = w; }
        }
    }
};
struct EpiResF32 {
    static constexpr bool PERM = false, TOUCH = true;
    const float* base; float* out;
    __device__ __forceinline__ void touch(const pg8::Unit& u, int tid, unsigned& d) const {
        const float* p = base + ((size_t)u.pm * 256 + (tid >> 1)) * DM + (size_t)u.pn * 256 + (tid & 1) * 128;
        touch_line(d, p); touch_line(d, p + 32); touch_line(d, p + 64); touch_line(d, p + 96);
    }
    __device__ __forceinline__ void operator()(const pg8::f32x4 (&acc)[2][2][4][2], const pg8::Unit& u, int wr, int wc, int fr, int fq) const {
        const size_t off0 = ((size_t)u.pm * 256 + wr * 64 + fr) * DM + (size_t)u.pn * 256 + wc * 32 + 4 * fq;
#pragma unroll
        for (int ab = 0; ab < 4; ++ab) { const int ai = ab >> 1, m0 = (ab & 1) * 2;
            pg8::f32x4 bs[4][2][2];
#pragma unroll
            for (int m = m0; m < m0 + 2; ++m)
#pragma unroll
                for (int bj = 0; bj < 2; ++bj)
#pragma unroll
                    for (int n = 0; n < 2; ++n) bs[m][bj][n] = *(const pg8::f32x4*)(base + off0 + (size_t)(ai * 128 + m * 16) * DM + bj * 128 + n * 16);
#pragma unroll
            for (int m = m0; m < m0 + 2; ++m)
#pragma unroll
                for (int bj = 0; bj < 2; ++bj)
#pragma unroll
                    for (int n = 0; n < 2; ++n) *(pg8::f32x4*)(out + off0 + (size_t)(ai * 128 + m * 16) * DM + bj * 128 + n * 16) = bs[m][bj][n] * ALPHA + acc[ai][bj][m][n];
        }
    }
};
struct EpiRelu2 {
    static constexpr bool PERM = true, TOUCH = false;
    __device__ __forceinline__ void touch(const pg8::Unit&, int, unsigned&) const {}
    bf16* O;
    __device__ __forceinline__ void operator()(const pg8::f32x4 (&acc)[2][2][4][2], const pg8::Unit& u, int wr, int wc, int fr, int fq) const {
        store_tile_bf16<3>(acc, O, FF, (size_t)u.pm * 256, (size_t)u.pn * 256, wr, wc, fr, fq);
    }
};

constexpr int SGU_PITCH = 272;
constexpr int SGU_A = 0, SGU_B = 128 * SGU_PITCH, SGU_RED = 2 * 128 * SGU_PITCH, SGU_STAT = SGU_RED + 2 * 32 * 128 * 4;
static_assert(SGU_STAT + 1024 <= RING_BYTES, "SGU LDS");
__device__ __forceinline__ void sgu_unit(const Args& a, LAS unsigned char* lds, int unit, int tid, int wave, int lane) {
    unsigned char* ws = a.ws;
    const bf16* gvT = (const bf16*)(ws + WS_S2); const bf16* gu = (const bf16*)(ws + WS_S1); bf16* aout = (bf16*)(ws + WS_S5); const bf16* wsgu = (const bf16*)(ws + WS_WSGU);
    const float* lng = a.in[2]; const float* lnb = a.in[3]; const float* bs = a.in[5];
    const size_t tok0 = (size_t)unit * 128;
    const int chunk = tid & 15, rsub = tid >> 4;
    LAS float* red = (LAS float*)(lds + SGU_RED); LAS float* stat = (LAS float*)(lds + SGU_STAT);
    float s1[8], s2[8];
#pragma unroll
    for (int e = 0; e < 8; ++e) { s1[e] = 0.f; s2[e] = 0.f; }
#pragma unroll 8
    for (int it = 0; it < 32; ++it) { const int c = it * 32 + rsub; const v4u v = *(const v4u*)(gvT + ((size_t)unit * 1024 + c) * 128 + 8 * chunk);
        const float f[8] = {pg8::bf_lo(v.x), pg8::bf_hi(v.x), pg8::bf_lo(v.y), pg8::bf_hi(v.y), pg8::bf_lo(v.z), pg8::bf_hi(v.z), pg8::bf_lo(v.w), pg8::bf_hi(v.w)};
#pragma unroll
        for (int e = 0; e < 8; ++e) { s1[e] += f[e]; s2[e] = fmaf(f[e], f[e], s2[e]); } }
#pragma unroll
    for (int e = 0; e < 8; ++e) { red[rsub * 128 + 8 * chunk + e] = s1[e]; red[4096 + rsub * 128 + 8 * chunk + e] = s2[e]; }
    __syncthreads();
    if (tid < 128) { float t1 = 0.f, t2 = 0.f;
#pragma unroll 8
        for (int r = 0; r < 32; ++r) { t1 += red[r * 128 + tid]; t2 += red[4096 + r * 128 + tid]; }
        const float mean = t1 * (1.f / 1024.f); const float var = fmaxf(t2 * (1.f / 1024.f) - mean * mean, 0.f);
        stat[tid] = mean; stat[128 + tid] = 1.0f / sqrtf(var + LN_EPS); }
    __syncthreads();
    float mu[8], rs[8];
#pragma unroll
    for (int e = 0; e < 8; ++e) { mu[e] = stat[8 * chunk + e]; rs[e] = stat[128 + 8 * chunk + e]; }
    const int l15 = lane & 15, kq = lane >> 4;
    const size_t tokw = tok0 + 16 * wave + l15;
    for (int g = 0; g < 8; ++g) {
        v2u guv[8];
#pragma unroll
        for (int ct = 0; ct < 8; ++ct) guv[ct] = *(const v2u*)(gu + tokw * DM + g * 128 + 16 * ct + 4 * kq);
        const float bias = bs[g * 128 + 16 * wave + l15];
#pragma unroll
        for (int p = 0; p < 4; ++p) { const int rl = p * 32 + rsub; const int c = g * 128 + rl;
            const v4u v = *(const v4u*)(gvT + ((size_t)unit * 1024 + c) * 128 + 8 * chunk); const float gg = lng[c], bb = lnb[c];
            const float f[8] = {pg8::bf_lo(v.x), pg8::bf_hi(v.x), pg8::bf_lo(v.y), pg8::bf_hi(v.y), pg8::bf_lo(v.z), pg8::bf_hi(v.z), pg8::bf_lo(v.w), pg8::bf_hi(v.w)};
            float o[8];
#pragma unroll
            for (int e = 0; e < 8; ++e) o[e] = fmaf((f[e] - mu[e]) * rs[e], gg, bb);
            v4u w; w.x = pk2(o[0], o[1]); w.y = pk2(o[2], o[3]); w.z = pk2(o[4], o[5]); w.w = pk2(o[6], o[7]);
            *(LAS v4u*)(lds + SGU_B + rl * SGU_PITCH + chunk * 16) = w;
            const v4u wv = *(const v4u*)(wsgu + (size_t)(g * 128 + rl) * 128 + 8 * chunk);
            *(LAS v4u*)(lds + SGU_A + rl * SGU_PITCH + chunk * 16) = wv; }
        __syncthreads();
        const int kkmax = (16 * wave + 15) >> 5;
        f32x4 acc[8];
#pragma unroll
        for (int ct = 0; ct < 8; ++ct) acc[ct] = (f32x4){0.f, 0.f, 0.f, 0.f};
        for (int kk = 0; kk <= kkmax; ++kk) {
            const bf16x8 wf = *(const LAS bf16x8*)(lds + SGU_A + (16 * wave + l15) * SGU_PITCH + (32 * kk + 8 * kq) * 2);
#pragma unroll
            for (int ct = 0; ct < 8; ++ct) { const bf16x8 vf = *(const LAS bf16x8*)(lds + SGU_B + (16 * ct + l15) * SGU_PITCH + (32 * kk + 8 * kq) * 2);
                acc[ct] = __builtin_amdgcn_mfma_f32_16x16x32_bf16(vf, wf, acc[ct], 0, 0, 0); }
        }
#pragma unroll
        for (int ct = 0; ct < 8; ++ct) { const size_t off = tokw * DM + g * 128 + 16 * ct + 4 * kq; const v2u u = guv[ct];
            v2u w; w.x = pk2(pg8::bf_lo(u.x) * (acc[ct][0] + bias), pg8::bf_hi(u.x) * (acc[ct][1] + bias)); w.y = pk2(pg8::bf_lo(u.y) * (acc[ct][2] + bias), pg8::bf_hi(u.y) * (acc[ct][3] + bias));
            *(v2u*)(aout + off) = w; }
        __syncthreads();
    }
}

__device__ __forceinline__ unsigned short* score_base(const Args& a, int b) { return b < 7 ? (unsigned short*)a.out + (size_t)b * SCORE_BATCH_ELEMS : (unsigned short*)(a.ws + WS_S6); }
__device__ __forceinline__ size_t score_stripoff(int s) { const int a = s >> 2, r = s & 3; return (size_t)1024 * (a + 1) * (2 * a + r); }
constexpr int IDX_PITCH = 144;
constexpr int IDX_BUF = 64 * IDX_PITCH;
__device__ __forceinline__ void idx_block_item(const Args& a, LAS unsigned char* lds, int idx, int tid, int wave, int lane) {
    const bf16* qi = (const bf16*)(a.ws + WS_S4); const bf16* ki = (const bf16*)(a.ws + WS_KI); const float* wi = (const float*)(a.ws + WS_WI);
    const int b = idx / 144; int r = idx % 144; int q4 = 0;
    while (r >= 4 * (q4 + 1)) { r -= 4 * (q4 + 1); ++q4; }
    const int per = q4 + 1, j = 4 * q4 + r / per, c = r % per;
    const int ng_blk = 2 * j + 2, ng_w = 2 * j + 1 + (wave >= 4 ? 1 : 0);
    const int g_beg = 8 * c, g_end = (8 * c + 8 < ng_blk) ? 8 * c + 8 : ng_blk;
    const int t0 = 128 * j + 16 * wave;
    const int l15 = lane & 15, kq = lane >> 4;
    const size_t tok = (size_t)b * SEQ + t0 + l15;
    bf16x8 qf[8][2];
#pragma unroll
    for (int h = 0; h < 8; ++h)
#pragma unroll
        for (int kk = 0; kk < 2; ++kk) qf[h][kk] = *(const bf16x8*)(qi + tok * 512 + h * 64 + kk * 32 + kq * 8);
    const f32x4 w0 = *(const f32x4*)(wi + tok * 8), w1 = *(const f32x4*)(wi + tok * 8 + 4);
    const float wv[8] = {w0[0], w0[1], w0[2], w0[3], w1[0], w1[1], w1[2], w1[3]};
    unsigned short* sblk = score_base(a, b) + score_stripoff(t0 >> 4) + l15 * 32 + kq * 8;
    const bf16* kg = ki + ((size_t)b * SEQ + (tid >> 3)) * 64 + (tid & 7) * 8;
    const int st_off = (tid >> 3) * IDX_PITCH + (tid & 7) * 16;
    const int rd_off = (8 * (l15 >> 2) + (l15 & 3)) * IDX_PITCH + kq * 16;
    v4u stg = *(const v4u*)(kg + (size_t)(64 * g_beg) * 64);
    *(LAS v4u*)(lds + st_off) = stg;
    __syncthreads();
    v4u o0 = {0u, 0u, 0u, 0u}, o1 = {0u, 0u, 0u, 0u}; bool pend = false;
    unsigned short* pdst = sblk;
    for (int g = g_beg; g < g_end; ++g) {
        const int cur = ((g - g_beg) & 1) * IDX_BUF;
        if (g + 1 < g_end) stg = *(const v4u*)(kg + (size_t)(64 * (g + 1)) * 64);
        if (pend) { *(v4u*)pdst = o0; *(v4u*)(pdst + 512) = o1; }
        pend = g < ng_w;
        if (g < ng_w) {
            unsigned hw[8];
#pragma unroll
            for (int jt = 0; jt < 4; ++jt) {
                const bf16x8 k0 = *(const LAS bf16x8*)(lds + cur + rd_off + (32 * (jt >> 1) + 4 * (jt & 1)) * IDX_PITCH), k1 = *(const LAS bf16x8*)(lds + cur + rd_off + (32 * (jt >> 1) + 4 * (jt & 1)) * IDX_PITCH + 64);
                f32x4 sc = {0.f, 0.f, 0.f, 0.f};
#pragma unroll
                for (int h = 0; h < 8; ++h) { f32x4 C = {0.f, 0.f, 0.f, 0.f};
                    C = __builtin_amdgcn_mfma_f32_16x16x32_bf16(k0, qf[h][0], C, 0, 0, 0); C = __builtin_amdgcn_mfma_f32_16x16x32_bf16(k1, qf[h][1], C, 0, 0, 0);
#pragma unroll
                    for (int e = 0; e < 4; ++e) { int xi = __float_as_int(C[e]); xi = xi > 0 ? xi : 0; sc[e] = fmaf(wv[h], __int_as_float(xi), sc[e]); } }
                const _Float16 h0 = (_Float16)sc[0], h1 = (_Float16)sc[1], h2 = (_Float16)sc[2], h3 = (_Float16)sc[3];
                hw[2 * jt] = (unsigned)__builtin_bit_cast(unsigned short, h0) | ((unsigned)__builtin_bit_cast(unsigned short, h1) << 16);
                hw[2 * jt + 1] = (unsigned)__builtin_bit_cast(unsigned short, h2) | ((unsigned)__builtin_bit_cast(unsigned short, h3) << 16);
            }
            o0 = (v4u){hw[0], hw[1], hw[2], hw[3]}; o1 = (v4u){hw[4], hw[5], hw[6], hw[7]};
            pdst = sblk + (size_t)g * 1024;
        }
        if (g + 1 < g_end) *(LAS v4u*)(lds + (cur ^ IDX_BUF) + st_off) = stg;
        __syncthreads();
    }
    if (pend) { *(v4u*)pdst = o0; *(v4u*)(pdst + 512) = o1; }
}

typedef unsigned short u16x2 __attribute__((ext_vector_type(2)));
__device__ __forceinline__ unsigned wave_sum_small(unsigned lc) {
    unsigned cnt = 0u;
#pragma unroll
    for (int p = 0; p < 7; ++p) cnt += (unsigned)__builtin_popcountll(__ballot((lc >> p) & 1u)) << p;
    return cnt;
}
__device__ __forceinline__ void select_load(const Args& a, int row, int lane, v4u (&raw)[8]) {
    const int b = row >> 12, t = row & 4095;
    const unsigned short* sblk = score_base(a, b) + score_stripoff(t >> 4) + ((lane >> 2) & 1) * 512 + (t & 15) * 32 + (lane & 3) * 8;
    const int nch = (t >> 9) + 1;
#pragma unroll
    for (int c = 0; c < 8; ++c) { const int cc = c < nch ? c : nch - 1; raw[c] = *(const v4u*)(sblk + (size_t)(8 * cc + (lane >> 3)) * 1024); }
}
__device__ __forceinline__ void select_row(const Args& a, int row, int lane, const v4u (&raw)[8]) {
    const int t = row & 4095;
    unsigned char* mrow = (unsigned char*)(a.ws + WS_MASK) + (size_t)row * 512;
    if (t < 256) {
#pragma unroll
        for (int c = 0; c < 8; ++c) { const int base = 512 * c + 8 * lane; unsigned bits = 0;
            if (base <= t) { const int n = t - base + 1; bits = n >= 8 ? 0xffu : ((1u << n) - 1u); }
            mrow[64 * c + lane] = (unsigned char)bits; }
        return;
    }
    const int nch = (t >> 9) + 1;
    unsigned K[32];
#pragma unroll
    for (int c = 0; c < 8; ++c) {
        const unsigned h[4] = {raw[c].x, raw[c].y, raw[c].z, raw[c].w};
        const int nv = t - (512 * c + 8 * lane) + 1;
#pragma unroll
        for (int p = 0; p < 4; ++p) {
            const u16x2 hv = __builtin_bit_cast(u16x2, h[p]);
            const u16x2 sg = __builtin_bit_cast(u16x2, __builtin_bit_cast(short __attribute__((ext_vector_type(2))), hv) >> 15);
            const unsigned k = h[p] ^ (__builtin_bit_cast(unsigned, sg) | 0x80008000u);
            const unsigned vm = nv >= 2 * p + 2 ? 0xffffffffu : (nv == 2 * p + 1 ? 0x0000ffffu : 0u);
            K[4 * c + p] = k & vm; }
    }
    u16x2 acc = {0, 0};
#pragma unroll
    for (int c = 0; c < 8; ++c) if (c < nch) {
#pragma unroll
        for (int p = 0; p < 4; ++p) acc += __builtin_bit_cast(u16x2, K[4 * c + p]) >> 15; }
    const unsigned cpos = wave_sum_small((unsigned)acc.x + (unsigned)acc.y);
    const unsigned top = cpos >= 256u ? 1u : 0u, base = top ? 0u : cpos;
    bool exact = (cpos == 256u);
    unsigned k15[32];
#pragma unroll
    for (int c = 0; c < 8; ++c) {
#pragma unroll
        for (int p = 0; p < 4; ++p) { const unsigned m = __builtin_bit_cast(unsigned, __builtin_bit_cast(short __attribute__((ext_vector_type(2))), K[4 * c + p]) >> 15);
            k15[4 * c + p] = K[4 * c + p] & (top ? m : ~m) & 0x7fff7fffu; } }
    unsigned T15 = 0u;
    if (!exact) {
        for (int bit = 14; bit >= 0; --bit) {
            const unsigned cand = T15 | (1u << bit);
            const unsigned A = (0x8000u - cand) * 0x10001u;
            u16x2 ac = {0, 0};
#pragma unroll
            for (int c = 0; c < 8; ++c) if (c < nch) {
#pragma unroll
                for (int p = 0; p < 4; ++p) ac += __builtin_bit_cast(u16x2, k15[4 * c + p] + A) >> 15; }
            const unsigned cnt = base + wave_sum_small((unsigned)ac.x + (unsigned)ac.y);
            if (cnt >= 256u) { T15 = cand; if (cnt == 256u) { exact = true; break; } }
        }
    }
    const unsigned T = (top << 15) | T15;
    unsigned need = 0u;
    if (!exact) {
        const unsigned A = (0x8000u - (T15 + 1u)) * 0x10001u;
        u16x2 ac = {0, 0};
#pragma unroll
        for (int c = 0; c < 8; ++c) if (c < nch) {
#pragma unroll
            for (int p = 0; p < 4; ++p) ac += __builtin_bit_cast(u16x2, k15[4 * c + p] + A) >> 15; }
        const unsigned cgt = base + wave_sum_small((unsigned)ac.x + (unsigned)ac.y);
        need = 256u - cgt; }
#pragma unroll
    for (int c = 0; c < 8; ++c) {
        unsigned bits = 0u;
        if (c < nch) {
            unsigned eqb = 0u, gtb = 0u;
#pragma unroll
            for (int p = 0; p < 4; ++p) { const unsigned k0 = K[4 * c + p] & 0xffffu, k1 = K[4 * c + p] >> 16;
                eqb |= (k0 == T ? 1u : 0u) << (2 * p); eqb |= (k1 == T ? 1u : 0u) << (2 * p + 1);
                gtb |= (k0 > T ? 1u : 0u) << (2 * p); gtb |= (k1 > T ? 1u : 0u) << (2 * p + 1); }
            if (exact) bits = eqb | gtb;
            else if (need == 0u || __ballot(eqb != 0u) == 0ull) bits = gtb;
            else {
                unsigned before = 0u, tot = 0u;
#pragma unroll
                for (int e = 0; e < 8; ++e) { const unsigned long long m = __ballot((eqb >> e) & 1u);
                    before += __builtin_amdgcn_mbcnt_hi((unsigned)(m >> 32), __builtin_amdgcn_mbcnt_lo((unsigned)m, 0u)); tot += (unsigned)__builtin_popcountll(m); }
                unsigned sel = 0u, run = before;
#pragma unroll
                for (int e = 0; e < 8; ++e) { if ((eqb >> e) & 1u) { if (run < need) sel |= 1u << e; ++run; } }
                bits = gtb | sel;
                need = need > tot ? need - tot : 0u;
            }
        }
        mrow[64 * c + lane] = (unsigned char)bits;
    }
}
__device__ __forceinline__ void select_rows(const Args& a, int gw, int NGW, int lane) {
    v4u raw[8], cur[8];
    select_load(a, gw, lane, raw);
    for (int row = gw; row < TOK; row += NGW) {
#pragma unroll
        for (int c = 0; c < 8; ++c) cur[c] = raw[c];
        const int nrow = row + NGW < TOK ? row + NGW : row;
        select_load(a, nrow, lane, raw);
        select_row(a, row, lane, cur);
    }
}

__device__ __forceinline__ void ln_rows(float* y, bf16* bcopy, const float* g, const float* bta, int gw, int NGW, int lane) {
    f32x4 nx[4];
    { const f32x4* yr = (const f32x4*)(y + (size_t)gw * DM) + lane;
#pragma unroll
      for (int j = 0; j < 4; ++j) nx[j] = yr[64 * j]; }
    f32x4 gg[4], bb[4];
#pragma unroll
    for (int j = 0; j < 4; ++j) { gg[j] = ((const f32x4*)g)[lane + 64 * j]; bb[j] = ((const f32x4*)bta)[lane + 64 * j]; }
    for (int m = gw; m < TOK; m += NGW) {
        f32x4 v[4]; float s = 0.f;
#pragma unroll
        for (int j = 0; j < 4; ++j) { v[j] = nx[j]; s += (v[j].x + v[j].y) + (v[j].z + v[j].w); }
        { const int mn = m + NGW < TOK ? m + NGW : m; const f32x4* yr = (const f32x4*)(y + (size_t)mn * DM) + lane;
#pragma unroll
          for (int j = 0; j < 4; ++j) nx[j] = yr[64 * j]; }
        const float mean = wave_sum(s) * (1.f / DM); float s2 = 0.f;
#pragma unroll
        for (int j = 0; j < 4; ++j) { v[j] = v[j] - mean; s2 += (v[j].x * v[j].x + v[j].y * v[j].y) + (v[j].z * v[j].z + v[j].w * v[j].w); }
        const float rstd = 1.f / sqrtf(wave_sum(s2) * (1.f / DM) + LN_EPS);
        float* orow = y + (size_t)m * DM;
#pragma unroll
        for (int j = 0; j < 4; ++j) { const f32x4 o = v[j] * rstd * gg[j] + bb[j]; ((f32x4*)orow)[lane + 64 * j] = o;
            if (bcopy) { v2u w; w.x = pk2(o.x, o.y); w.y = pk2(o.z, o.w); ((v2u*)(bcopy + (size_t)m * DM))[lane + 64 * j] = w; } }
    }
}

constexpr int N_PHASES = 12;
__global__ void __launch_bounds__(NWAVES * 64, 2) hybrid_fwd(Args args) {
    extern __shared__ __attribute__((aligned(16))) unsigned char lds_raw[];
    LAS unsigned char* lds = (LAS unsigned char*)lds_raw;
    volatile LAS unsigned* MISC = (volatile LAS unsigned*)(lds + MISC_OFF);
    const int tid = threadIdx.x, lane = tid & 63, wave = __builtin_amdgcn_readfirstlane(tid >> 6);
    const int G = gridDim.x, bx = blockIdx.x;
    const int vcu = (G % 8 == 0) ? (bx % 8) * (G / 8) + bx / 8 : bx;
    const int gw = vcu * NWAVES + wave, NGW = G * NWAVES;
    unsigned char* ws = args.ws;
    unsigned* ctl = (unsigned*)(ws + WS_CTL);
    for (int u = tid; u < (LDS_BYTES - LDSCTL_OFF) / 4; u += NWAVES * 64) ((LAS unsigned*)(lds + LDSCTL_OFF))[u] = 0u;
    __syncthreads();
    XcdBarrier bar; bar.bar = ctl + CW_BAR; bar.x = 0; bar.st = nullptr;
    const int lo = args.ph_lo, hi = args.ph_hi;
    const bool use_bar = (hi - lo) > 1;
    if (use_bar) bar = xcd_barrier_post(ctl + CW_BAR, MISC + 8);
#define IN(k) (((PH_MASK >> (k)) & 1) && lo <= (k) && (k) < hi)
#define SEAM(k) do { if (IN(k) && IN((k) + 1)) xcd_barrier(bar); } while (0)

#define DUP(id, ...) if (DUP_PHASE == (id)) { __VA_ARGS__ xcd_barrier(bar); }
#define NREP(id) (DUP_PHASE == (id) ? 2 : 1)
    if (IN(0)) { DUP(0, p0_prologue(args, lds, gw, NGW, wave, lane);) p0_prologue(args, lds, gw, NGW, wave, lane); }
    SEAM(0);
#define P1_BODY { InProjSched S; S.X = (const char*)(ws + WS_S0); S.W = (const char*)(ws + WS_WIN); S.mode = 1; S.init(TOK / 256, 15, G, bx); \
        EpiInProj E{ws}; pg8::gemm_phase<EpiInProj, InProjSched, true>(lds + RING_OFF, DM, S, E); }
    if (IN(1)) { DUP(1, P1_BODY) P1_BODY }
    SEAM(1);
#define P2A_BODY { for (int u = bx; u < TOK / 128; u += G) sgu_unit(args, lds, u, tid, wave, lane); }
#define P2B_BODY { for (int it = bx; it < 8 * 144; it += G) idx_block_item(args, lds, it, tid, wave, lane); }
    if (IN(2)) { DUP(20, P2A_BODY) DUP(21, P2B_BODY) P2A_BODY P2B_BODY }
    SEAM(2);
#define P3A_BODY { select_rows(args, gw, NGW, lane); __syncthreads(); }
#define P3B_BODY { pg8::PlainSched S; S.setup(ws + WS_S5, ws + WS_WA, TOK, DM, DM, G, bx); \
        EpiGate1 E{(const bf16*)(ws + WS_S3), (bf16*)(ws + WS_S1)}; pg8::gemm_phase<EpiGate1, pg8::PlainSched, true>(lds + RING_OFF, DM, S, E); }
    if (IN(3)) { DUP(30, P3A_BODY) DUP(31, P3B_BODY) P3A_BODY P3B_BODY }
    SEAM(3);
#define P4_BODY { InProjSched S; S.X = (const char*)(ws + WS_S0); S.W = (const char*)(ws + WS_WIN); S.mode = 2; S.init(TOK / 256, 16, G, bx); \
        EpiInProj E{ws}; pg8::gemm_phase<EpiInProj, InProjSched, true>(lds + RING_OFF, DM, S, E); }
    if (IN(4)) { DUP(4, P4_BODY) P4_BODY }
    SEAM(4);
#define P5_BODY { att::attn_phase((char*)lds_raw + RING_OFF, (const att::bf16*)(ws + WS_S2), (const att::bf16*)(ws + WS_S3), (const att::bf16*)(ws + WS_S4), (att::bf16*)(ws + WS_S6), \
                                 (const unsigned long long*)(ws + WS_MASK), bx, G); }
    if (IN(5)) { P5_BODY }
    SEAM(5);
    if (IN(6)) { pg8::PlainSched S; S.setup(ws + WS_S6, ws + WS_WB, TOK, DM, DM, G, bx);
        EpiGate2 E{(const bf16*)(ws + WS_S5), (bf16*)(ws + WS_S1)}; pg8::gemm_phase<EpiGate2, pg8::PlainSched, true>(lds + RING_OFF, DM, S, E); }
    SEAM(6);
#define P7_BODY { pg8::PlainSched S; S.setup(ws + WS_S1, ws + WS_WO, TOK, DM, DM, G, bx); \
        EpiResF32 E{args.in[0], args.out}; pg8::gemm_phase<EpiResF32, pg8::PlainSched, true>(lds + RING_OFF, DM, S, E); }
    if (IN(7)) { DUP(7, P7_BODY) P7_BODY }
    SEAM(7);
    if (IN(8)) { ln_rows(args.out, (bf16*)(ws + WS_S0), args.in[9], args.in[10], gw, NGW, lane); }
    SEAM(8);
#define P9_BODY { pg8::PlainSched S; S.setup(ws + WS_S0, ws + WS_WUP, TOK, FF, DM, G, bx); \
        EpiRelu2 E{(bf16*)(ws + WS_S3)}; pg8::gemm_phase<EpiRelu2, pg8::PlainSched, true>(lds + RING_OFF, DM, S, E); }
    if (IN(9)) { DUP(9, P9_BODY) P9_BODY }
    SEAM(9);
    if (IN(10)) { pg8::PlainSched S; S.setup(ws + WS_S3, ws + WS_WDN, TOK, DM, FF, G, bx);
        EpiResF32 E{args.out, args.out}; pg8::gemm_phase<EpiResF32, pg8::PlainSched, true>(lds + RING_OFF, FF, S, E); }
    SEAM(10);
    if (IN(11)) { ln_rows(args.out, nullptr, args.in[13], args.in[14], gw, NGW, lane); }
#undef IN
#undef SEAM
}

extern "C" void kernel_launch(void* const* d_in, const int* in_sizes, int n_in, void* d_out, int out_size, void* d_ws, size_t ws_size, hipStream_t stream) {
    static int grid = 0;
    if (grid == 0) {
        if (n_in != 15 || in_sizes[0] != TOK * DM || out_size != TOK * DM || ws_size < WS_END) { fprintf(stderr, "kernel_launch: unexpected shapes (n_in %d, in0 %d, out %d, ws %zu)\n", n_in, n_in > 0 ? in_sizes[0] : -1, out_size, ws_size); grid = -1; return; }
        int dev = 0, cus = 0, per_cu = 0;
        if (hipGetDevice(&dev) != hipSuccess || hipDeviceGetAttribute(&cus, hipDeviceAttributeMultiprocessorCount, dev) != hipSuccess) { grid = -1; return; }
        if (hipFuncSetAttribute((const void*)hybrid_fwd, hipFuncAttributeMaxDynamicSharedMemorySize, LDS_BYTES) != hipSuccess) { fprintf(stderr, "kernel_launch: hipFuncSetAttribute failed\n"); grid = -1; return; }
        if (hipOccupancyMaxActiveBlocksPerMultiprocessor(&per_cu, (const void*)hybrid_fwd, NWAVES * 64, LDS_BYTES) != hipSuccess || per_cu < 1) { fprintf(stderr, "kernel_launch: occupancy query says %d blocks per CU\n", per_cu); (void)hipGetLastError(); grid = -1; return; }
        grid = cus;
    }
    if (grid < 0) return;
    (void)hipMemsetAsync((char*)d_ws + WS_CTL, 0, CTL_ZERO_BYTES, stream);
    Args a{};
    for (int i = 0; i < 15; ++i) a.in[i] = (const float*)d_in[i];
    a.out = (float*)d_out; a.ws = (unsigned char*)d_ws;
#if MK_N_LAUNCHES == 1
    a.ph_lo = 0; a.ph_hi = N_PHASES;
    void* kargs[] = {&a};
    hipError_t e = hipLaunchCooperativeKernel((const void*)hybrid_fwd, dim3(grid), dim3(NWAVES * 64), kargs, LDS_BYTES, stream);
    if (e != hipSuccess) fprintf(stderr, "kernel_launch: cooperative launch failed: %s (grid %d)\n", hipGetErrorString(e), grid);
#else
    for (int p = 0; p < N_PHASES; ++p) { a.ph_lo = p; a.ph_hi = p + 1; hipLaunchKernelGGL(hybrid_fwd, dim3(grid), dim3(NWAVES * 64), LDS_BYTES, stream, a); }
#endif
}
```

```cpp
#include <hip/hip_runtime.h>
#include <hip/hip_bf16.h>
#include <cstdio>
#include <cstdint>

#ifndef PH_MASK
#define PH_MASK 0xfff
#endif
#ifndef DUP_PHASE
#define DUP_PHASE -1
#endif
#ifndef MK_N_LAUNCHES
#define MK_N_LAUNCHES 1
#endif

namespace pg8 {
#define PG8_LAS __attribute__((address_space(3)))
typedef unsigned short bf16_t;
typedef short bf16x8 __attribute__((ext_vector_type(8)));
typedef float f32x4 __attribute__((ext_vector_type(4)));
typedef float f32x2 __attribute__((ext_vector_type(2)));
typedef unsigned u32x4 __attribute__((ext_vector_type(4)));
typedef unsigned u32x2 __attribute__((ext_vector_type(2)));
constexpr int BM = 256, BK = 64, HALF = 128, HTB = HALF * BK * 2  , STAGE_BYTES = 8 * HTB, NXCD = 8, WGM = 8;

__host__ __device__ __forceinline__ int lds_byte(int r, int c) { const int st = (r >> 4) * 2 + (c >> 5), rr = r & 15, cc = c & 31, ob = rr * 64 + cc * 2; return st * 1024 + (ob ^ (((ob >> 9) & 1) << 5)); }
__host__ __device__ __forceinline__ void stage_rc(int b, int& R, int& C) { const int st = b / 1024, sb = b % 1024, swz = sb ^ (((sb >> 9) & 1) << 5); R = (st >> 1) * 16 + swz / 64; C = (st & 1) * 32 + (swz % 64) / 2; }
__host__ __device__ __forceinline__ int perm32(int rho) { const int n = rho >> 4, i = rho & 15; return 8 * (i >> 2) + 4 * n + (i & 3); }

struct Unit { int pm, pn, kind; };

struct StaticOrder {
    int nM, nN, nwg, G, c;
    __device__ __forceinline__ void init(int nM_, int nN_, int G_, int c_) { nM = nM_; nN = nN_; nwg = nM * nN; G = G_; c = c_; }
    __device__ __forceinline__ bool next_mn(int i, int& pm, int& pn) const {
        const long L = (long)i * G + c; if (L >= nwg) return false;
        int wgid = (int)L; { const int q = nwg / NXCD, r = nwg % NXCD, xcd = wgid % NXCD, off = wgid / NXCD; wgid = (xcd < r ? xcd * (q + 1) : r * (q + 1) + (xcd - r) * q) + off; }
        const int nig = WGM * nN, gid = wgid / nig, fm = gid * WGM, gsz = (nM - fm) < WGM ? (nM - fm) : WGM;
        pm = fm + ((wgid % nig) % gsz); pn = (wgid % nig) / gsz; return true;
    }
};
struct PlainSched : StaticOrder {
    const char* A; const char* B; size_t tstep;
    __device__ __forceinline__ void setup(const void* A_, const void* B_, int M, int N, int K, int G_, int c_) { A = (const char*)A_; B = (const char*)B_; tstep = (size_t)BM * K * 2; init(M / BM, N / BM, G_, c_); }
    __device__ __forceinline__ bool next(int i, Unit& u) const { u.kind = 0; return next_mn(i, u.pm, u.pn); }
    __device__ __forceinline__ const char* aptr(const Unit& u) const { return A + (size_t)u.pm * tstep; }
    __device__ __forceinline__ const char* bptr(const Unit& u) const { return B + (size_t)u.pn * tstep; }
};

__device__ __forceinline__ unsigned cvt_pk_bf16(float lo, float hi) { unsigned r; asm volatile("v_cvt_pk_bf16_f32 %0, %1, %2" : "=v"(r) : "v"(lo), "v"(hi)); return r; }
__device__ __forceinline__ float bf_lo(unsigned w) { return __uint_as_float(w << 16); }
__device__ __forceinline__ float bf_hi(unsigned w) { return __uint_as_float(w & 0xffff0000u); }
__device__ __forceinline__ float gelu_tanh(float x) {
    const float z = x * (-2.302208198f) * fmaf(0.044715f * x, x, 1.0f);
    return x * __builtin_amdgcn_rcpf(1.0f + __builtin_amdgcn_exp2f(z));
}
__device__ __forceinline__ float sigmoidf_(float x) { return __builtin_amdgcn_rcpf(1.0f + __builtin_amdgcn_exp2f(x * (-1.4426950409f))); }

template <class Epi, class Sched, bool ALIGN_EPI = true>
__device__ __forceinline__ void gemm_phase(PG8_LAS unsigned char* lds, const int K, const Sched& S, const Epi& E) {
    const int tid = threadIdx.x, wid = __builtin_amdgcn_readfirstlane(tid >> 6), lane = tid & 63, wr = wid >> 2, wc = wid & 3, fr = lane & 15, fq = lane >> 4;
    const int nt = K / BK;
    unsigned voffA[2], voffB[2];
#pragma unroll
    for (int i = 0; i < 2; ++i) { int R, C; stage_rc(tid * 16 + i * 8192, R, C); const int Rb = Epi::PERM ? ((R & ~31) + perm32(R & 31)) : R;
        voffA[i] = (unsigned)(R * K + C) * 2u; voffB[i] = (unsigned)(Rb * K + C) * 2u; }
    const size_t kstep = (size_t)(BK * 2);
    const size_t hstep = (size_t)HALF * K * 2;
    const unsigned ldsw = (unsigned)wid * 1024u;
    const int aoff = lds_byte(wr * 64 + fr, fq * 8), boff = lds_byte(wc * 32 + fr, fq * 8);
#define PG8_SA(b, h) (((b) * 2 + (h)) * HTB)
#define PG8_SB(b, h) ((4 + (b) * 2 + (h)) * HTB)
#define PG8_STAGE(bufoff, gbase, voff) do { _Pragma("unroll") for (int _i = 0; _i < 2; ++_i) \
        __builtin_amdgcn_global_load_lds((const unsigned*)((const char*)(gbase) + (voff)[_i]), (PG8_LAS unsigned*)(lds + (bufoff) + ldsw + _i * 8192), 16, 0, 0); } while (0)
#define PG8_LDA(dst, b, h) do { _Pragma("unroll") for (int m = 0; m < 4; ++m) _Pragma("unroll") for (int k = 0; k < 2; ++k) dst[m][k] = *(const PG8_LAS bf16x8*)(lds + PG8_SA(b, h) + aoff + m * 2048 + k * 1024); } while (0)
#define PG8_LDB(dst, b, h) do { _Pragma("unroll") for (int n = 0; n < 2; ++n) _Pragma("unroll") for (int k = 0; k < 2; ++k) dst[n][k] = *(const PG8_LAS bf16x8*)(lds + PG8_SB(b, h) + boff + n * 2048 + k * 1024); } while (0)
#define PG8_MMA(ai, bj, At, Bt) do { __builtin_amdgcn_s_setprio(1); _Pragma("unroll") for (int m = 0; m < 4; ++m) _Pragma("unroll") for (int n = 0; n < 2; ++n) _Pragma("unroll") for (int k = 0; k < 2; ++k) \
        acc[ai][bj][m][n] = __builtin_amdgcn_mfma_f32_16x16x32_bf16(Bt[n][k], At[m][k], acc[ai][bj][m][n], 0, 0, 0); __builtin_amdgcn_s_setprio(0); } while (0)
#define PG8_WAIT_V(n) asm volatile("s_waitcnt vmcnt(" #n ")" ::: "memory")
#define PG8_WAIT_L(n) asm volatile("s_waitcnt lgkmcnt(" #n ")" ::: "memory")
#define PG8_BAR __builtin_amdgcn_s_barrier()
#define PG8_SCHED __builtin_amdgcn_sched_barrier(0)
    Unit cur, nxt; int ui = 0;
    if (!S.next(0, cur)) return;
    f32x4 acc[2][2][4][2];
#pragma unroll
    for (int a = 0; a < 2; ++a)
#pragma unroll
        for (int b = 0; b < 2; ++b)
#pragma unroll
            for (int m = 0; m < 4; ++m)
#pragma unroll
                for (int n = 0; n < 2; ++n) acc[a][b][m][n] = (f32x4){0.f, 0.f, 0.f, 0.f};
    bf16x8 At[4][2], B0[2][2], B1[2][2];
    const char* cA = S.aptr(cur); const char* cB = S.bptr(cur);
    PG8_STAGE(PG8_SB(0, 0), cB, voffB); PG8_STAGE(PG8_SB(0, 1), cB + hstep, voffB); PG8_STAGE(PG8_SA(0, 0), cA, voffA); PG8_STAGE(PG8_SA(0, 1), cA + hstep, voffA);
    if (wr == 1) PG8_BAR;
    PG8_WAIT_V(2); PG8_BAR;
    PG8_STAGE(PG8_SB(1, 0), cB + kstep, voffB); PG8_STAGE(PG8_SA(1, 0), cA + kstep, voffA); PG8_STAGE(PG8_SB(1, 1), cB + hstep + kstep, voffB);
    PG8_WAIT_V(6); PG8_BAR;
    for (;;) {
        const bool has_next = S.next(ui + 1, nxt);
        const char* nA = has_next ? S.aptr(nxt) : cA; const char* nB = has_next ? S.bptr(nxt) : cB;
        unsigned td = 0u;
        if constexpr (Epi::TOUCH) E.touch(cur, tid, td);
        for (int t = 0; t < nt; t += 2) {
            const bool last = (t == nt - 2);
            const char* a1 = cA + (size_t)(t + 1) * kstep;
            const char* a2 = last ? nA : cA + (size_t)(t + 2) * kstep; const char* b2 = last ? nB : cB + (size_t)(t + 2) * kstep;
            const char* a3 = a2 + kstep; const char* b3 = b2 + kstep;
            PG8_LDB(B0, 0, 0); PG8_LDB(B1, 0, 1); PG8_SCHED; PG8_LDA(At, 0, 0); PG8_STAGE(PG8_SA(1, 1), a1 + hstep, voffA);
            PG8_WAIT_V(8); PG8_WAIT_L(0); PG8_BAR; PG8_MMA(0, 0, At, B0); PG8_MMA(0, 1, At, B1); PG8_BAR; PG8_SCHED;
            PG8_LDA(At, 0, 1); PG8_STAGE(PG8_SB(0, 0), b2, voffB); PG8_STAGE(PG8_SB(0, 1), b2 + hstep, voffB); PG8_STAGE(PG8_SA(0, 0), a2, voffA);
            PG8_WAIT_V(8); PG8_WAIT_L(0); PG8_BAR; PG8_MMA(1, 0, At, B0); PG8_MMA(1, 1, At, B1); PG8_BAR; PG8_SCHED;
            PG8_LDB(B0, 1, 0); PG8_LDB(B1, 1, 1); PG8_SCHED; PG8_LDA(At, 1, 0); PG8_STAGE(PG8_SA(0, 1), a2 + hstep, voffA);
            PG8_WAIT_V(8); PG8_WAIT_L(0); PG8_BAR; PG8_MMA(0, 0, At, B0); PG8_MMA(0, 1, At, B1); PG8_BAR; PG8_SCHED;
            PG8_LDA(At, 1, 1); PG8_STAGE(PG8_SB(1, 0), b3, voffB); PG8_STAGE(PG8_SB(1, 1), b3 + hstep, voffB); PG8_STAGE(PG8_SA(1, 0), a3, voffA);
            PG8_WAIT_V(8); PG8_WAIT_L(0); PG8_BAR; PG8_MMA(1, 0, At, B0); PG8_MMA(1, 1, At, B1); PG8_BAR; PG8_SCHED;
        }
        if constexpr (Epi::TOUCH) asm volatile("" :: "v"(td));
        if constexpr (ALIGN_EPI) { if (wr == 0) PG8_BAR; }
        E(acc, cur, wr, wc, fr, fq);
        if (!has_next) break;
#pragma unroll
        for (int a = 0; a < 2; ++a)
#pragma unroll
            for (int b = 0; b < 2; ++b)
#pragma unroll
                for (int m = 0; m < 4; ++m)
#pragma unroll
                    for (int n = 0; n < 2; ++n) acc[a][b][m][n] = (f32x4){0.f, 0.f, 0.f, 0.f};
        cur = nxt; cA = nA; cB = nB; ++ui;
        if constexpr (ALIGN_EPI) { if (wr == 1) PG8_BAR; }
    }
    PG8_WAIT_V(0);
    if constexpr (!ALIGN_EPI) { if (wr == 0) PG8_BAR; }
    PG8_BAR;
#undef PG8_SA
#undef PG8_SB
#undef PG8_STAGE
#undef PG8_LDA
#undef PG8_LDB
#undef PG8_MMA
#undef PG8_WAIT_V
#undef PG8_WAIT_L
#undef PG8_BAR
#undef PG8_SCHED
}
}

namespace att {
using bf16 = __hip_bfloat16;
typedef short bf16x8 __attribute__((ext_vector_type(8)));
typedef short s16x4 __attribute__((ext_vector_type(4)));
typedef float f32x16 __attribute__((ext_vector_type(16)));
typedef float f32x4 __attribute__((ext_vector_type(4)));
typedef unsigned u32x4 __attribute__((ext_vector_type(4)));
typedef unsigned u32x2 __attribute__((ext_vector_type(2)));
constexpr int D = 128, LD = 1024, SEQ = 4096, NH = 8, NB = 8;
constexpr float SCALE = 0.08838834764831845f;
constexpr float THR = 8.f;
constexpr int NW = 8, QBLK = 32, KVBLK = 64, QB = NW * QBLK;
constexpr int SHM_V = KVBLK * D * 2, SHM_K = KVBLK * D * 2;
constexpr int LDS_BYTES = 2 * SHM_V + 2 * SHM_K + NW * 64 * 4;

#define KSWZ(row, colB) ((row) * 256 + ((colB) ^ (((row) & 7) << 4)))
#define SBAR() __builtin_amdgcn_sched_barrier(0)
__device__ __forceinline__ int v_st(int k, int c) { const int kk = (k & ~0xC) | ((k & 4) << 1) | ((k & 8) >> 1); return ((kk >> 3) * 4 + (c >> 5)) * 512 + ((kk & 7) * 32 + (c & 31)) * 2; }
__device__ __forceinline__ int v_rd_base(int lane) { return ((lane & 3) << 3) | (((lane >> 2) & 3) << 6) | (((lane >> 4) & 1) << 5) | (((lane >> 5) & 1) << 8); }
constexpr int v_rd_off(int d0, int ks, int half) { return d0 * 512 + ks * 4096 + half * 2048; }
__device__ __forceinline__ int crow(int r, int hi) { return (r & 3) + 8 * (r >> 2) + 4 * hi; }
__device__ __forceinline__ unsigned cvtpk(float lo, float hi) { unsigned r; asm volatile("v_cvt_pk_bf16_f32 %0, %1, %2" : "=v"(r) : "v"(lo), "v"(hi)); return r; }
__device__ __forceinline__ bf16x8 load8(const bf16* p) { return *reinterpret_cast<const bf16x8*>(p); }

__device__ __forceinline__ void sel_mask_tile(f32x16& p0, f32x16& p1, unsigned wlo, unsigned whi, int hi) {
    const unsigned NEGB = 0xff800000u;
    const unsigned lo = wlo >> (4 * hi), h2 = whi >> (4 * hi);
#pragma unroll
    for (int r = 0; r < 16; ++r) {
        const int c = (r & 3) + 8 * (r >> 2);
        const unsigned m0 = (unsigned)__builtin_amdgcn_sbfe((int)lo, c, 1), m1 = (unsigned)__builtin_amdgcn_sbfe((int)h2, c, 1);
        p0[r] = __uint_as_float((__float_as_uint(p0[r]) & m0) | (NEGB & ~m0));
        p1[r] = __uint_as_float((__float_as_uint(p1[r]) & m1) | (NEGB & ~m1));
    }
}
__device__ __forceinline__ void partialSM(f32x16& p0, f32x16& p1, float& m_reg, float& mn, float& alpha) {
    float pmax = p0[0];
#pragma unroll
    for (int r = 1; r < 16; ++r) pmax = fmaxf(pmax, p0[r]);
#pragma unroll
    for (int r = 0; r < 16; ++r) pmax = fmaxf(pmax, p1[r]);
    { auto rr = __builtin_amdgcn_permlane32_swap(__float_as_uint(pmax), __float_as_uint(pmax), false, false);
      pmax = fmaxf(__uint_as_float(rr[0]), __uint_as_float(rr[1])); }
    constexpr float C2 = 1.4426950408889634f * SCALE;
    if (__builtin_expect(__all((pmax - m_reg) * SCALE <= THR), 1)) { mn = m_reg; alpha = 1.f; }
    else { mn = fmaxf(m_reg, pmax); alpha = __builtin_amdgcn_exp2f((m_reg - mn) * C2); m_reg = mn; }
    const float mnL = -mn * C2;
#pragma unroll
    for (int r = 0; r < 16; ++r) p0[r] = fmaf(p0[r], C2, mnL);
#pragma unroll
    for (int r = 0; r < 16; ++r) p1[r] = fmaf(p1[r], C2, mnL);
#pragma unroll
    for (int r = 0; r < 16; ++r) p0[r] = __builtin_amdgcn_exp2f(p0[r]);
}
__device__ __forceinline__ void finishSM(f32x16& p0, f32x16& p1, float alpha, float& l_reg, bf16x8& pa0, bf16x8& pa1, bf16x8& pa2, bf16x8& pa3) {
#pragma unroll
    for (int r = 0; r < 16; ++r) p1[r] = __builtin_amdgcn_exp2f(p1[r]);
    float ps = 0;
#pragma unroll
    for (int r = 0; r < 16; ++r) ps += p0[r];
#pragma unroll
    for (int r = 0; r < 16; ++r) ps += p1[r];
    { auto rr = __builtin_amdgcn_permlane32_swap(__float_as_uint(ps), __float_as_uint(ps), false, false);
      ps = __uint_as_float(rr[0]) + __uint_as_float(rr[1]); }
    l_reg = l_reg * alpha + ps;
#define PK4(P, B_, OUT) do { unsigned a0 = cvtpk(P[B_+0], P[B_+1]), a1 = cvtpk(P[B_+2], P[B_+3]);                          \
        unsigned b0 = cvtpk(P[B_+4], P[B_+5]), b1 = cvtpk(P[B_+6], P[B_+7]);                                             \
        auto r0 = __builtin_amdgcn_permlane32_swap(a0, b0, false, false); auto r1 = __builtin_amdgcn_permlane32_swap(a1, b1, false, false); \
        u32x4 w = {r0[0], r1[0], r0[1], r1[1]}; OUT = *reinterpret_cast<bf16x8*>(&w); } while (0)
    PK4(p0, 0, pa0); PK4(p0, 8, pa1); PK4(p1, 0, pa2); PK4(p1, 8, pa3);
#undef PK4
}
template <int KB>
__device__ __forceinline__ void qkt(f32x16& p0, f32x16& p1, const char* K_lds, int r32, int hi, const bf16x8* qr) {
    p0 = f32x16{}; p1 = f32x16{};
    const char* kb[4];
#pragma unroll
    for (int dd = 0; dd < 4; ++dd) kb[dd] = K_lds + KB * SHM_K + KSWZ(r32, (dd * 16 + hi * 8) * 2);
#pragma unroll
    for (int d0 = 0; d0 < 8; ++d0) { const char* a = kb[d0 & 3] + (d0 >> 2) * 128;
        bf16x8 b0 = *reinterpret_cast<const bf16x8*>(a);
        bf16x8 b1 = *reinterpret_cast<const bf16x8*>(a + 32 * 256);
        p0 = __builtin_amdgcn_mfma_f32_32x32x16_bf16(b0, qr[d0], p0, 0, 0, 0);
        p1 = __builtin_amdgcn_mfma_f32_32x32x16_bf16(b1, qr[d0], p1, 0, 0, 0); }
}
template <int VB>
__device__ __forceinline__ void pv_tile(f32x16* o, int vb0, bf16x8 pa0, bf16x8 pa1, bf16x8 pa2, bf16x8 pa3) {
#define TRRD(dst, off) asm volatile("ds_read_b64_tr_b16 %0, %1 offset:%2" : "=&v"(dst) : "v"(vb0), "i"(off) : "memory")
#define PV_D0(d0) do { s16x4 l0, l1, l2, l3, h0, h1, h2, h3; constexpr int b_ = VB * SHM_V + v_rd_off(d0, 0, 0); \
        TRRD(l0, b_); TRRD(h0, b_ + 2048); TRRD(l1, b_ + 4096); TRRD(h1, b_ + 6144); TRRD(l2, b_ + 8192); TRRD(h2, b_ + 10240); TRRD(l3, b_ + 12288); TRRD(h3, b_ + 14336); \
        asm volatile("s_waitcnt lgkmcnt(0)" ::: "memory"); SBAR();   \
        o[d0] = __builtin_amdgcn_mfma_f32_32x32x16_bf16(pa0, (bf16x8){l0[0], l0[1], l0[2], l0[3], h0[0], h0[1], h0[2], h0[3]}, o[d0], 0, 0, 0);   \
        o[d0] = __builtin_amdgcn_mfma_f32_32x32x16_bf16(pa1, (bf16x8){l1[0], l1[1], l1[2], l1[3], h1[0], h1[1], h1[2], h1[3]}, o[d0], 0, 0, 0);   \
        o[d0] = __builtin_amdgcn_mfma_f32_32x32x16_bf16(pa2, (bf16x8){l2[0], l2[1], l2[2], l2[3], h2[0], h2[1], h2[2], h2[3]}, o[d0], 0, 0, 0);   \
        o[d0] = __builtin_amdgcn_mfma_f32_32x32x16_bf16(pa3, (bf16x8){l3[0], l3[1], l3[2], l3[3], h3[0], h3[1], h3[2], h3[3]}, o[d0], 0, 0, 0); } while (0)
    PV_D0(0); PV_D0(1); PV_D0(2); PV_D0(3);
#undef PV_D0
#undef TRRD
}

struct BlockRef { const bf16* Q; const bf16* K; const bf16* V; bf16* O; const unsigned long long* MW; int P0; };
struct Seam { bf16x8 qr[8]; bf16x8 st_v0, st_v1, st_k0, st_k1; };
#define ROW(p, k0, rr) ((p) + (size_t)((k0) + (rr)) * LD + sc)
#define VMW() asm volatile("s_waitcnt vmcnt(0)" ::: "memory")
#define VMWN(n) asm volatile("s_waitcnt vmcnt(%0)" :: "i"(n) : "memory")
#define SLOAD_H(Kp, Vp, k0) do { S.st_v0 = load8(ROW(Vp, k0, sr)); S.st_v1 = load8(ROW(Vp, k0, 32 + sr));              \
                         S.st_k0 = load8(ROW(Kp, k0, sr)); S.st_k1 = load8(ROW(Kp, k0, 32 + sr)); } while (0)
#define SWRITE_HK(bf) do { *(bf16x8*)(K_lds + (bf) * SHM_K + kws) = S.st_k0; *(bf16x8*)(K_lds + (bf) * SHM_K + kws + 32 * 256) = S.st_k1; } while (0)
#define SWRITE_HV(bf) do { *(bf16x8*)(V_lds + (bf) * SHM_V + vst0) = S.st_v0; *(bf16x8*)(V_lds + (bf) * SHM_V + vst1) = S.st_v1; } while (0)
#define SWRITE_H(bf) do { SWRITE_HV(bf); SWRITE_HK(bf); } while (0)
__device__ __forceinline__ void attn_prime(const BlockRef& cur, char* lds, Seam& S) {
    const int tid = threadIdx.x, wid = __builtin_amdgcn_readfirstlane(tid >> 6), lane = tid & 63, r32 = lane & 31, hi = lane >> 5;
    const int sr = tid >> 4, sc = (tid & 15) * 8, kws = KSWZ(sr, sc * 2); char* K_lds = lds + 2 * SHM_V;
#pragma unroll
    for (int d0 = 0; d0 < 8; ++d0) S.qr[d0] = load8(cur.Q + (size_t)(wid * QBLK + r32) * LD + d0 * 16 + hi * 8);
    SLOAD_H(cur.K, cur.V, 0); VMW(); SWRITE_HK(0);
    __syncthreads();
}
__device__ __forceinline__ void attn_block(const BlockRef& cur, const BlockRef& nxt, char* lds, Seam& S) {
    const int tid = threadIdx.x, wid = __builtin_amdgcn_readfirstlane(tid >> 6), lane = tid & 63, r32 = lane & 31, hi = lane >> 5;
    const int NT = (cur.P0 + QB - 1) / KVBLK + 1;
    char* V_lds = lds; char* K_lds = lds + 2 * SHM_V;
    float* ws = (float*)(lds + 2 * SHM_V + 2 * SHM_K) + wid * 64; float* li_l = ws, * al_l = ws + 32;
    float m_reg = -1e30f, l_reg = 0; f32x16 o[4] = {};
    const int sr = tid >> 4, sc = (tid & 15) * 8, vst0 = v_st(sr, sc), vst1 = v_st(32 + sr, sc), kws = KSWZ(sr, sc * 2);
    const int vb0 = (int)(uintptr_t)V_lds + v_rd_base(lane);
    const bf16* Kh = cur.K; const bf16* Vh = cur.V;
    const unsigned mrow_off = (unsigned)(wid * QBLK + r32) * 512u;
    u32x2 mw;
#define LDMASK(t) (*(const u32x2*)((const char*)cur.MW + (mrow_off + (unsigned)(t) * 8u)))
#define RESC(a) do { if (__any((a) < 1.f)) { if (hi == 0) al_l[r32] = (a); asm volatile("s_waitcnt lgkmcnt(0)" ::: "memory");              \
                     for (int d_ = 0; d_ < 4; ++d_) for (int r = 0; r < 16; ++r) o[d_][r] *= al_l[crow(r, hi)]; } } while (0)
#define KBASE(t) ((t) * KVBLK)
#define MASKT(P0_, P1_) sel_mask_tile(P0_, P1_, mw.x, mw.y, hi)
    constexpr int NQL = 8;
#define SEAM_K0() do { VMWN(NQL); SWRITE_HK(0); SBAR(); } while (0)
    f32x16 pA0, pA1, pB0, pB1; float mnA, mnB, alA, alB; bf16x8 pa0, pa1, pa2, pa3;
    SWRITE_HV(0); SBAR();
    mw = LDMASK(0);
    if (NT > 1) { SLOAD_H(Kh, Vh, KBASE(1)); }
    SBAR(); qkt<0>(pA0, pA1, K_lds, r32, hi, S.qr);
    MASKT(pA0, pA1); partialSM(pA0, pA1, m_reg, mnA, alA);
    if (NT > 1) { VMW(); SWRITE_H(1); }
    __syncthreads();
#define HALF_STEP(PX0, PX1, mnX, alX, PY0, PY1, alY, t, KB, VB, SB) do {                                                      \
        SBAR(); qkt<KB>(PX0, PX1, K_lds, r32, hi, S.qr);                                                                      \
        finishSM(PY0, PY1, alY, l_reg, pa0, pa1, pa2, pa3); SBAR();                                                           \
        if ((t) + 1 < NT) { SLOAD_H(Kh, Vh, KBASE((t) + 1)); SBAR(); }                                                        \
        mw = LDMASK(t); SBAR();                                                                                               \
        pv_tile<VB>(o, vb0, pa0, pa1, pa2, pa3); MASKT(PX0, PX1); partialSM(PX0, PX1, m_reg, mnX, alX);                       \
        __syncthreads();                                                                                                      \
        if ((t) + 1 < NT) { VMW(); SWRITE_H(SB); }                                                                            \
        RESC(alX); __syncthreads(); } while (0)
    for (int t = 1; t + 1 < NT; t += 2) {
        HALF_STEP(pB0, pB1, mnB, alB, pA0, pA1, alA, t, 1, 0, 0);
        HALF_STEP(pA0, pA1, mnA, alA, pB0, pB1, alB, t + 1, 0, 1, 1);
    }
    mw = LDMASK(NT - 1);
    SBAR(); qkt<1>(pB0, pB1, K_lds, r32, hi, S.qr); SBAR();
    SLOAD_H(nxt.K, nxt.V, 0); SBAR();
#pragma unroll
    for (int d0 = 0; d0 < 8; ++d0) S.qr[d0] = load8(nxt.Q + (size_t)(wid * QBLK + r32) * LD + d0 * 16 + hi * 8);
    SBAR();
    finishSM(pA0, pA1, alA, l_reg, pa0, pa1, pa2, pa3); SBAR();
    pv_tile<0>(o, vb0, pa0, pa1, pa2, pa3);
    MASKT(pB0, pB1); partialSM(pB0, pB1, m_reg, mnB, alB); __syncthreads(); RESC(alB);
    finishSM(pB0, pB1, alB, l_reg, pa0, pa1, pa2, pa3); SBAR(); pv_tile<1>(o, vb0, pa0, pa1, pa2, pa3);
    SBAR(); SEAM_K0();
    if (hi == 0) li_l[r32] = l_reg; asm volatile("s_waitcnt lgkmcnt(0)" ::: "memory");
    float rli[16];
#pragma unroll
    for (int r = 0; r < 16; ++r) rli[r] = __builtin_amdgcn_rcpf(li_l[crow(r, hi)]);
    bf16* Ow = cur.O + (size_t)(wid * QBLK) * LD;
#pragma unroll
    for (int r = 0; r < 16; ++r) { const int orow = crow(r, hi);
#pragma unroll
        for (int d0 = 0; d0 < 4; ++d0) { const float v = o[d0][r] * rli[r];
            const float vn = __shfl_xor(v, 1);
            if ((r32 & 1) == 0) *(unsigned*)(Ow + (size_t)orow * LD + d0 * 32 + r32) = cvtpk(v, vn); } }
    __syncthreads();
#undef RESC
#undef KBASE
#undef MASKT
#undef SEAM_K0
#undef LDMASK
#undef HALF_STEP
}
#undef ROW
#undef VMW
#undef VMWN
#undef SLOAD_H
#undef SWRITE_HK
#undef SWRITE_HV
#undef SWRITE_H

struct Item { int bh, qb0, qb1; };
__device__ __forceinline__ Item decode(int L) { L &= 511; Item it; const int xcd = L & 7, k = L >> 3, gi = k >> 3, r = k & 7; it.bh = gi * 8 + xcd; it.qb0 = r; it.qb1 = 15 - r; return it; }
__device__ __forceinline__ BlockRef mkref(const Item& it, int pass, const bf16* Q, const bf16* K, const bf16* V, bf16* O, const unsigned long long* MW) {
    const int qb = pass ? it.qb1 : it.qb0, b = it.bh >> 3, h = it.bh & 7;
    BlockRef r; const size_t row0 = (size_t)b * SEQ + (size_t)qb * QB;
    r.Q = Q + row0 * LD + h * D; r.O = O + row0 * LD + h * D; r.K = K + (size_t)b * SEQ * LD + h * D; r.V = V + (size_t)b * SEQ * LD + h * D;
    r.MW = MW + row0 * 64; r.P0 = qb * QB; return r;
}
__device__ __forceinline__ void attn_phase(char* lds, const bf16* Q, const bf16* K, const bf16* V, bf16* O, const unsigned long long* MW, int first, int stride) {
    constexpr int total = (DUP_PHASE == 5) ? 1024 : 512;
    int L = first; if (L >= total) return;
    Item it = decode(L); int pass = 0;
    BlockRef cur = mkref(it, 0, Q, K, V, O, MW);
    Seam S;
    attn_prime(cur, lds, S);
    for (;;) {
        const bool more_pass = pass == 0, more_item = L + stride < total, last = !more_pass && !more_item;
        Item itn = it; int passn = pass + 1, Ln = L;
        if (!more_pass) { passn = 0; Ln = more_item ? L + stride : L; itn = decode(Ln); }
        const BlockRef nxt = last ? cur : mkref(itn, passn, Q, K, V, O, MW);
        attn_block(cur, nxt, lds, S);
        if (last) break;
        cur = nxt; it = itn; pass = passn; L = Ln;
    }
}
#undef KSWZ
#undef SBAR
}

constexpr int NWAVES = 8;
constexpr int BATCH = 8, SEQ = 4096, DM = 1024, FF = 4096, TOK = BATCH * SEQ;
constexpr int NWIN = 7936;
constexpr float LN_EPS = 1e-5f;
constexpr float ALPHA = 1.189207115002721f;
constexpr float IDX_SCALE = 0.04419417382415922f;
enum { K_GELU = 0, K_GELUT = 1, K_Q = 2, K_K = 3, K_V = 4, K_SGA = 5, K_SGB = 6, K_QI = 7, K_KIW = 8 };

constexpr size_t MiB = 1u << 20;
constexpr size_t WS_CTL = 0, CTL_ZERO_BYTES = 1 * MiB;
constexpr size_t WS_WIN = 2 * MiB;
constexpr size_t WS_WA = 18 * MiB, WS_WB = 20 * MiB, WS_WO = 22 * MiB, WS_WUP = 24 * MiB, WS_WDN = 32 * MiB;
constexpr size_t WS_WSGU = 40 * MiB;
constexpr size_t WS_KI = 41 * MiB;
constexpr size_t WS_WI = 45 * MiB;
constexpr size_t WS_MASK = 46 * MiB;
constexpr size_t SLOT = 64 * MiB;
constexpr size_t WS_S0 = 1 * SLOT, WS_S1 = 2 * SLOT, WS_S2 = 3 * SLOT, WS_S3 = 4 * SLOT, WS_S4 = 5 * SLOT, WS_S5 = 6 * SLOT, WS_S6 = 7 * SLOT, WS_END = 8 * SLOT;
constexpr size_t SCORE_BATCH_ELEMS = 64ull * 65 * 2048;
constexpr int CW_BAR = 4096;

constexpr int RING_OFF = 0, RING_BYTES = 131072;
constexpr int LDSCTL_OFF = RING_BYTES, MISC_OFF = LDSCTL_OFF + 320;
constexpr int LDS_BYTES = 147456;
static_assert(MISC_OFF + 128 <= LDS_BYTES, "LDS map");

#define GAS __attribute__((address_space(1)))
#define LAS __attribute__((address_space(3)))
typedef unsigned short bf16;
typedef unsigned v4u __attribute__((ext_vector_type(4)));
typedef unsigned v2u __attribute__((ext_vector_type(2)));
typedef float f32x4 __attribute__((ext_vector_type(4)));
typedef short bf16x8 __attribute__((ext_vector_type(8)));
#define LDS_WAIT() asm volatile("s_waitcnt lgkmcnt(0)" ::: "memory")
#define VM_WAIT() asm volatile("s_waitcnt vmcnt(0)" ::: "memory")
__device__ __forceinline__ unsigned pk2(float lo, float hi) { return pg8::cvt_pk_bf16(lo, hi); }
__device__ __forceinline__ float bf2f(unsigned short h) { return __uint_as_float((unsigned)h << 16); }

#define XB_TMO      128
#define XB_XCNT(j)  (256  + 64 * (j))
#define XB_XSUB(j)  (1280 + 64 * (j))
#define XB_XGEN(j)  (2304 + 64 * (j))
#define XB_TOP      3328
#define XB_TOPGEN   3392
#define XCD_BAR_WORDS 3456
#define XB_SPIN_CAP (1u << 20)
__device__ __forceinline__ unsigned xb_ld(unsigned* p)              { return __hip_atomic_load(p, __ATOMIC_RELAXED, __HIP_MEMORY_SCOPE_AGENT); }
__device__ __forceinline__ unsigned xb_add(unsigned* p, unsigned v) { return __hip_atomic_fetch_add(p, v, __ATOMIC_RELAXED, __HIP_MEMORY_SCOPE_AGENT); }
__device__ __forceinline__ unsigned xb_xcc_id() { return (unsigned)__builtin_amdgcn_s_getreg((3 << 11) | 20) & 0xFu; }
#define XB_SPIN(cond, bar) do { unsigned _sp = 0; while (cond) { __builtin_amdgcn_s_sleep(1); \
    if ((++_sp & 255u) == 0u) { if (xb_ld(&(bar)[XB_TMO])) break; if (_sp > XB_SPIN_CAP) { atomicAdd(&(bar)[XB_TMO], 1u); break; } } } } while (0)
struct XcdBarrier { unsigned* bar; unsigned x; volatile LAS unsigned* st; };
__device__ __forceinline__ XcdBarrier xcd_barrier_post(unsigned* bar, volatile LAS unsigned* st) {
    XcdBarrier b; b.bar = bar; b.x = xb_xcc_id(); b.st = st;
    if (threadIdx.x == 0) (void)xb_add(&bar[XB_XCNT(b.x)], 1u);
    return b;
}
__device__ __forceinline__ void xcd_barrier_complete(unsigned* bar, unsigned x, unsigned& nloc, unsigned& nx) {
    const unsigned G = gridDim.x * gridDim.y * gridDim.z;
    unsigned sum, cnt, mine, sp = 0u;
    for (;;) {
        sum = 0u; cnt = 0u; mine = 0u;
#pragma unroll
        for (unsigned j = 0; j < 16; ++j) { const unsigned c = xb_ld(&bar[XB_XCNT(j)]); sum += c; cnt += (c > 0u) ? 1u : 0u; mine = (j == x) ? c : mine; }
        if (sum == G) break;
        __builtin_amdgcn_s_sleep(1);
        if ((++sp & 255u) == 0u) { if (xb_ld(&bar[XB_TMO])) break; if (sp > XB_SPIN_CAP) { atomicAdd(&bar[XB_TMO], 1u); break; } }
    }
    nloc = mine > 0u ? mine : 1u; nx = cnt > 0u ? cnt : 1u;
}
__device__ __forceinline__ void xcd_barrier(const XcdBarrier& b) {
    asm volatile("s_waitcnt vmcnt(0)" ::: "memory");
    __syncthreads();
    if (threadIdx.x == 0) {
        unsigned* bar = b.bar;
        __builtin_amdgcn_s_waitcnt(0);
        unsigned nloc = b.st[0], nx = b.st[1];
        if (nloc == 0u) { xcd_barrier_complete(bar, b.x, nloc, nx); b.st[0] = nloc; b.st[1] = nx; }
        const unsigned old = xb_add(&bar[XB_XSUB(b.x)], 1u);
        const unsigned gen = old / nloc;
        if (old + 1u == (gen + 1u) * nloc) {
            __builtin_amdgcn_fence(__ATOMIC_RELEASE, "agent");
            asm volatile("s_waitcnt vmcnt(0)" ::: "memory");
            const unsigned og = xb_add(&bar[XB_TOP], 1u);
            const unsigned tg = og / nx;
            if (og + 1u == (tg + 1u) * nx) xb_add(&bar[XB_TOPGEN], 1u);
            else XB_SPIN(xb_ld(&bar[XB_TOPGEN]) == tg, bar);
            __builtin_amdgcn_fence(__ATOMIC_ACQUIRE, "agent");
            xb_add(&bar[XB_XGEN(b.x)], 1u);
            asm volatile("s_waitcnt vmcnt(0)" ::: "memory");
        } else {
            XB_SPIN(xb_ld(&bar[XB_XGEN(b.x)]) == gen, bar);
            __builtin_amdgcn_fence(__ATOMIC_ACQUIRE, "agent");
            asm volatile("s_waitcnt vmcnt(0)" ::: "memory");
        }
    }
    __syncthreads();
}

__device__ __forceinline__ float wave_sum(float v) {
#pragma unroll
    for (int o = 1; o < 64; o <<= 1) v += __shfl_xor(v, o);
    return v;
}

struct Args {
    const float* in[15];
    float* out; unsigned char* ws; int ph_lo, ph_hi;
};

__device__ __forceinline__ int win_srccol(int r) { return r < 5120 ? r : (r < 7168 ? r - 5120 + 5704 : (r < 7752 ? r - 7168 + 5120 : -1)); }
template <bool WIN>
__device__ __forceinline__ void p0_transpose_item(const float* W, int K, int ldw, bf16* WT, int nblk, LAS float* scr, int item, int lane) {
    const int kb = item / nblk, nb = item % nblk, k0 = 64 * kb, n0 = 32 * nb;
    const int n = n0 + (lane & 31); const int col = WIN ? win_srccol(n) : n;
    float wv[32];
#pragma unroll
    for (int i = 0; i < 32; ++i) { const int kk = 2 * i + (lane >> 5); wv[i] = (col >= 0) ? W[(size_t)(k0 + kk) * ldw + col] : 0.f; }
#pragma unroll
    for (int i = 0; i < 32; ++i) { const int kk = 2 * i + (lane >> 5); scr[kk * 33 + (lane & 31)] = wv[i]; }
    LDS_WAIT(); asm volatile("" ::: "memory");
    const int c = lane & 7;
#pragma unroll
    for (int j = 0; j < 4; ++j) { const int nn = (lane >> 3) + 8 * j; const LAS float* s = scr + (8 * c) * 33 + nn;
        v4u o; o.x = pk2(s[0 * 33], s[1 * 33]); o.y = pk2(s[2 * 33], s[3 * 33]); o.z = pk2(s[4 * 33], s[5 * 33]); o.w = pk2(s[6 * 33], s[7 * 33]);
        *(GAS v4u*)(WT + (size_t)(n0 + nn) * K + k0 + 8 * c) = o; }
    LDS_WAIT(); asm volatile("" ::: "memory");
}
__device__ __forceinline__ void p0_prologue(const Args& a, LAS unsigned char* lds, int gw, int NGW, int wave, int lane) {
    unsigned char* ws = a.ws;
    LAS float* scr = (LAS float*)(lds + RING_OFF + wave * 16384);
    constexpr int I_WIN = (DM / 64) * (NWIN / 32), I_SQ = (DM / 64) * (DM / 32), I_UP = (DM / 64) * (FF / 32), I_DN = (FF / 64) * (DM / 32);
    constexpr int NITEMS = I_WIN + 3 * I_SQ + I_UP + I_DN;
    for (int it = gw; it < NITEMS; it += NGW) {
        int r = it;
        if (r < I_WIN) { p0_transpose_item<true>(a.in[1], DM, 7752, (bf16*)(ws + WS_WIN), NWIN / 32, scr, r, lane); continue; } r -= I_WIN;
        if (r < I_SQ) { p0_transpose_item<false>(a.in[6], DM, DM, (bf16*)(ws + WS_WA), DM / 32, scr, r, lane); continue; } r -= I_SQ;
        if (r < I_SQ) { p0_transpose_item<false>(a.in[7], DM, DM, (bf16*)(ws + WS_WB), DM / 32, scr, r, lane); continue; } r -= I_SQ;
        if (r < I_SQ) { p0_transpose_item<false>(a.in[8], DM, DM, (bf16*)(ws + WS_WO), DM / 32, scr, r, lane); continue; } r -= I_SQ;
        if (r < I_UP) { p0_transpose_item<false>(a.in[11], DM, FF, (bf16*)(ws + WS_WUP), FF / 32, scr, r, lane); continue; } r -= I_UP;
        p0_transpose_item<false>(a.in[12], FF, DM, (bf16*)(ws + WS_WDN), DM / 32, scr, r, lane);
    }
    { const float* w = a.in[4]; bf16* o = (bf16*)(ws + WS_WSGU);
      for (int i = gw * 64 + lane; i < 8 * 128 * 128; i += NGW * 64) { const int s = i & 127, t = (i >> 7) & 127; o[i] = (bf16)(pk2(s <= t ? w[i] : 0.f, 0.f) & 0xffffu); } }
    { const f32x4* x = (const f32x4*)a.in[0]; v4u* xb = (v4u*)(ws + WS_S0); const int n8 = TOK * DM / 8, step = NGW * 64;
      for (int i = gw * 64 + lane; i < n8; i += 4 * step) {
          f32x4 v[8];
#pragma unroll
          for (int u = 0; u < 4; ++u) { const int ii = i + u * step; const int jj = ii < n8 ? ii : i; v[2 * u] = x[2 * jj]; v[2 * u + 1] = x[2 * jj + 1]; }
#pragma unroll
          for (int u = 0; u < 4; ++u) { const int ii = i + u * step; if (ii < n8) { v4u o; o.x = pk2(v[2 * u].x, v[2 * u].y); o.y = pk2(v[2 * u].z, v[2 * u].w); o.z = pk2(v[2 * u + 1].x, v[2 * u + 1].y); o.w = pk2(v[2 * u + 1].z, v[2 * u + 1].w); xb[ii] = o; } } } }
}

struct InProjSched : pg8::StaticOrder {
    const char* X; const char* W; int mode;
    static constexpr size_t tstep = (size_t)256 * DM * 2;
    __device__ __forceinline__ bool next(int i, pg8::Unit& u) const {
        int pm, j; if (!next_mn(i, pm, j)) return false;
        int tile; if (mode == 1) tile = j < 8 ? j : (j < 12 ? j + 12 : j + 16); else tile = j < 12 ? j + 8 : j + 12;
        u.pm = pm; u.pn = tile;
        u.kind = tile < 4 ? K_GELU : tile < 8 ? K_GELUT : tile < 12 ? K_Q : tile < 16 ? K_K : tile < 20 ? K_V : tile < 24 ? K_SGA : tile < 28 ? K_SGB : tile < 30 ? K_QI : K_KIW;
        return true;
    }
    __device__ __forceinline__ const char* aptr(const pg8::Unit& u) const { return u.kind == K_GELUT ? W + (size_t)u.pn * tstep : X + (size_t)u.pm * tstep; }
    __device__ __forceinline__ const char* bptr(const pg8::Unit& u) const { return u.kind == K_GELUT ? X + (size_t)u.pm * tstep : W + (size_t)u.pn * tstep; }
};
template <int ACT>
__device__ __forceinline__ void store_tile_bf16(const pg8::f32x4 (&acc)[2][2][4][2], bf16* O, size_t ld, size_t row0, size_t col0, int wr, int wc, int fr, int fq, size_t bjstride = 128) {
    bf16* base = O + (row0 + wr * 64 + fr) * ld + col0 + wc * 32 + 8 * fq;
#pragma unroll
    for (int ai = 0; ai < 2; ++ai)
#pragma unroll
        for (int m = 0; m < 4; ++m) { bf16* rowp = base + (size_t)(ai * 128 + m * 16) * ld;
#pragma unroll
            for (int bj = 0; bj < 2; ++bj) { pg8::f32x4 v0 = acc[ai][bj][m][0], v1 = acc[ai][bj][m][1];
#pragma unroll
                for (int e = 0; e < 4; ++e) {
                    if (ACT == 1) { v0[e] = pg8::gelu_tanh(v0[e]); v1[e] = pg8::gelu_tanh(v1[e]); }
                    if (ACT == 2) { v0[e] = pg8::sigmoidf_(v0[e]); v1[e] = pg8::sigmoidf_(v1[e]); }
                    if (ACT == 3) { const float a0 = fmaxf(v0[e], 0.f), a1 = fmaxf(v1[e], 0.f); v0[e] = a0 * a0; v1[e] = a1 * a1; } }
                v4u w; w.x = pk2(v0[0], v0[1]); w.y = pk2(v0[2], v0[3]); w.z = pk2(v1[0], v1[1]); w.w = pk2(v1[2], v1[3]);
                *(v4u*)(rowp + bj * bjstride) = w; } }
}
struct EpiInProj {
    static constexpr bool PERM = true, TOUCH = false;
    __device__ __forceinline__ void touch(const pg8::Unit&, int, unsigned&) const {}
    unsigned char* ws;
    __device__ __forceinline__ void operator()(const pg8::f32x4 (&acc)[2][2][4][2], const pg8::Unit& u, int wr, int wc, int fr, int fq) const {
        const size_t tok0 = (size_t)u.pm * 256; const int tile = u.pn;
        switch (u.kind) {
        case K_GELU:  store_tile_bf16<1>(acc, (bf16*)(ws + WS_S1), DM, tok0, (size_t)tile * 256, wr, wc, fr, fq); break;
        case K_GELUT: store_tile_bf16<1>(acc, (bf16*)(ws + WS_S2) + (size_t)u.pm * 2 * 1024 * 128, 128, (size_t)(tile - 4) * 256, 0, wr, wc, fr, fq, (size_t)1024 * 128); break;
        case K_Q:     store_tile_bf16<0>(acc, (bf16*)(ws + WS_S2), DM, tok0, (size_t)(tile - 8) * 256, wr, wc, fr, fq); break;
        case K_K:     store_tile_bf16<0>(acc, (bf16*)(ws + WS_S3), DM, tok0, (size_t)(tile - 12) * 256, wr, wc, fr, fq); break;
        case K_V:     store_tile_bf16<0>(acc, (bf16*)(ws + WS_S4), DM, tok0, (size_t)(tile - 16) * 256, wr, wc, fr, fq); break;
        case K_SGA:   store_tile_bf16<2>(acc, (bf16*)(ws + WS_S3), DM, tok0, (size_t)(tile - 20) * 256, wr, wc, fr, fq); break;
        case K_SGB:   store_tile_bf16<2>(acc, (bf16*)(ws + WS_S5), DM, tok0, (size_t)(tile - 24) * 256, wr, wc, fr, fq); break;
        case K_QI:    store_tile_bf16<0>(acc, (bf16*)(ws + WS_S4), 512, tok0, (size_t)(tile - 28) * 256, wr, wc, fr, fq); break;
        default: {
            bf16* KI = (bf16*)(ws + WS_KI); float* WI = (float*)(ws + WS_WI);
#pragma unroll
            for (int ai = 0; ai < 2; ++ai)
#pragma unroll
                for (int m = 0; m < 4; ++m) { const size_t tok = tok0 + ai * 128 + wr * 64 + m * 16 + fr; const pg8::f32x4 v0 = acc[ai][0][m][0], v1 = acc[ai][0][m][1];
                    if (wc < 2) { v4u w; w.x = pk2(v0[0], v0[1]); w.y = pk2(v0[2], v0[3]); w.z = pk2(v1[0], v1[1]); w.w = pk2(v1[2], v1[3]); *(v4u*)(KI + tok * 64 + wc * 32 + 8 * fq) = w; }
                    else if (wc == 2 && fq == 0) { *(pg8::f32x4*)(WI + tok * 8) = v0 * IDX_SCALE; *(pg8::f32x4*)(WI + tok * 8 + 4) = v1 * IDX_SCALE; } }
        } }
    }
};
__device__ __forceinline__ void touch_line(unsigned& d, const void* p) { asm volatile("global_load_dword %0, %1, off" : "+v"(d) : "v"(p) : "memory"); }
struct EpiGate1 {
    static constexpr bool PERM = true, TOUCH = true;
    const bf16* G; bf16* O;
    __device__ __forceinline__ void touch(const pg8::Unit& u, int tid, unsigned& d) const {
        const bf16* p = G + ((size_t)u.pm * 256 + (tid >> 1)) * DM + (size_t)u.pn * 256 + (tid & 1) * 128;
        touch_line(d, p); touch_line(d, p + 64);
    }
    __device__ __forceinline__ void operator()(const pg8::f32x4 (&acc)[2][2][4][2], const pg8::Unit& u, int wr, int wc, int fr, int fq) const {
        const size_t off0 = ((size_t)u.pm * 256 + wr * 64 + fr) * DM + (size_t)u.pn * 256 + wc * 32 + 8 * fq;
#pragma unroll
        for (int ai = 0; ai < 2; ++ai) {
            v4u g[4][2];
#pragma unroll
            for (int m = 0; m < 4; ++m)
#pragma unroll
                for (int bj = 0; bj < 2; ++bj) g[m][bj] = *(const v4u*)(G + off0 + (size_t)(ai * 128 + m * 16) * DM + bj * 128);
#pragma unroll
            for (int m = 0; m < 4; ++m)
#pragma unroll
                for (int bj = 0; bj < 2; ++bj) { const size_t off = off0 + (size_t)(ai * 128 + m * 16) * DM + bj * 128;
                    const v4u gg = g[m][bj]; const pg8::f32x4 v0 = acc[ai][bj][m][0], v1 = acc[ai][bj][m][1];
                    v4u w; w.x = pk2(v0[0] * pg8::bf_lo(gg.x), v0[1] * pg8::bf_hi(gg.x)); w.y = pk2(v0[2] * pg8::bf_lo(gg.y), v0[3] * pg8::bf_hi(gg.y));
                    w.z = pk2(v1[0] * pg8::bf_lo(gg.z), v1[1] * pg8::bf_hi(gg.z)); w.w = pk2(v1[2] * pg8::bf_lo(gg.w), v1[3] * pg8::bf_hi(gg.w));
                    *(v4u*)(O + off) = w; }
        }
    }
};
struct EpiGate2 {
    static constexpr bool PERM = true, TOUCH = true;
    const bf16* G; bf16* O;
    __device__ __forceinline__ void touch(const pg8::Unit& u, int tid, unsigned& d) const {
        const size_t o = ((size_t)u.pm * 256 + (tid >> 1)) * DM + (size_t)u.pn * 256 + (tid & 1) * 128;
        touch_line(d, G + o); touch_line(d, G + o + 64); touch_line(d, O + o); touch_line(d, O + o + 64);
    }
    __device__ __forceinline__ void operator()(const pg8::f32x4 (&acc)[2][2][4][2], const pg8::Unit& u, int wr, int wc, int fr, int fq) const {
        const size_t off0 = ((size_t)u.pm * 256 + wr * 64 + fr) * DM + (size_t)u.pn * 256 + wc * 32 + 8 * fq;
#pragma unroll
        for (int ab = 0; ab < 4; ++ab) { const int ai = ab >> 1, m0 = (ab & 1) * 2;
            v4u g[4][2], p[4][2];
#pragma unroll
            for (int m = m0; m < m0 + 2; ++m)
#pragma unroll
                for (int bj = 0; bj < 2; ++bj) { const size_t off = off0 + (size_t)(ai * 128 + m * 16) * DM + bj * 128; g[m][bj] = *(const v4u*)(G + off); p[m][bj] = *(const v4u*)(O + off); }
#pragma unroll
            for (int m = m0; m < m0 + 2; ++m)
#pragma unroll
                for (int bj = 0; bj < 2; ++bj) { const size_t off = off0 + (size_t)(ai * 128 + m * 16) * DM + bj * 128;
                    const v4u gg = g[m][bj], pp = p[m][bj]; const pg8::f32x4 v0 = acc[ai][bj][m][0], v1 = acc[ai][bj][m][1];
                    v4u w; w.x = pk2(fmaf(v0[0], pg8::bf_lo(gg.x), pg8::bf_lo(pp.x)), fmaf(v0[1], pg8::bf_hi(gg.x), pg8::bf_hi(pp.x)));
                    w.y = pk2(fmaf(v0[2], pg8::bf_lo(gg.y), pg8::bf_lo(pp.y)), fmaf(v0[3], pg8::bf_hi(gg.y), pg8::bf_hi(pp.y)));
                    w.z = pk2(fmaf(v1[0], pg8::bf_lo(gg.z), pg8::bf_lo(pp.z)), fmaf(v1[1], pg8::bf_hi(gg.z), pg8::bf_hi(pp.z)));
                    w.w = pk2(fmaf(v1[2], pg8::bf_lo(gg.w), pg8::bf_lo(pp.w)), fmaf(v1[3], pg8::bf_hi(gg.w), pg8::bf_hi(pp.w)));
                    *(v4u*)(O + off) = w; }
        }
    }
};
struct EpiResF32 {
    static constexpr bool PERM = false, TOUCH = true;
    const float* base; float* out;
    __device__ __forceinline__ void touch(const pg8::Unit& u, int tid, unsigned& d) const {
        const float* p = base + ((size_t)u.pm * 256 + (tid >> 1)) * DM + (size_t)u.pn * 256 + (tid & 1) * 128;
        touch_line(d, p); touch_line(d, p + 32); touch_line(d, p + 64); touch_line(d, p + 96);
    }
    __device__ __forceinline__ void operator()(const pg8::f32x4 (&acc)[2][2][4][2], const pg8::Unit& u, int wr, int wc, int fr, int fq) const {
        const size_t off0 = ((size_t)u.pm * 256 + wr * 64 + fr) * DM + (size_t)u.pn * 256 + wc * 32 + 4 * fq;
#pragma unroll
        for (int ab = 0; ab < 4; ++ab) { const int ai = ab >> 1, m0 = (ab & 1) * 2;
            pg8::f32x4 bs[4][2][2];
#pragma unroll
            for (int m = m0; m < m0 + 2; ++m)
#pragma unroll
                for (int bj = 0; bj < 2; ++bj)
#pragma unroll
                    for (int n = 0; n < 2; ++n) bs[m][bj][n] = *(const pg8::f32x4*)(base + off0 + (size_t)(ai * 128 + m * 16) * DM + bj * 128 + n * 16);
#pragma unroll
            for (int m = m0; m < m0 + 2; ++m)
#pragma unroll
                for (int bj = 0; bj < 2; ++bj)
#pragma unroll
                    for (int n = 0; n < 2; ++n) *(pg8::f32x4*)(out + off0 + (size_t)(ai * 128 + m * 16) * DM + bj * 128 + n * 16) = bs[m][bj][n] * ALPHA + acc[ai][bj][m][n];
        }
    }
};
struct EpiRelu2 {
    static constexpr bool PERM = true, TOUCH = false;
    __device__ __forceinline__ void touch(const pg8::Unit&, int, unsigned&) const {}
    bf16* O;
    __device__ __forceinline__ void operator()(const pg8::f32x4 (&acc)[2][2][4][2], const pg8::Unit& u, int wr, int wc, int fr, int fq) const {
        store_tile_bf16<3>(acc, O, FF, (size_t)u.pm * 256, (size_t)u.pn * 256, wr, wc, fr, fq);
    }
};

constexpr int SGU_PITCH = 272;
constexpr int SGU_A = 0, SGU_B = 128 * SGU_PITCH, SGU_RED = 2 * 128 * SGU_PITCH, SGU_STAT = SGU_RED + 2 * 32 * 128 * 4;
static_assert(SGU_STAT + 1024 <= RING_BYTES, "SGU LDS");
__device__ __forceinline__ void sgu_unit(const Args& a, LAS unsigned char* lds, int unit, int tid, int wave, int lane) {
    unsigned char* ws = a.ws;
    const bf16* gvT = (const bf16*)(ws + WS_S2); const bf16* gu = (const bf16*)(ws + WS_S1); bf16* aout = (bf16*)(ws + WS_S5); const bf16* wsgu = (const bf16*)(ws + WS_WSGU);
    const float* lng = a.in[2]; const float* lnb = a.in[3]; const float* bs = a.in[5];
    const size_t tok0 = (size_t)unit * 128;
    const int chunk = tid & 15, rsub = tid >> 4;
    LAS float* red = (LAS float*)(lds + SGU_RED); LAS float* stat = (LAS float*)(lds + SGU_STAT);
    float s1[8], s2[8];
#pragma unroll
    for (int e = 0; e < 8; ++e) { s1[e] = 0.f; s2[e] = 0.f; }
#pragma unroll 8
    for (int it = 0; it < 32; ++it) { const int c = it * 32 + rsub; const v4u v = *(const v4u*)(gvT + ((size_t)unit * 1024 + c) * 128 + 8 * chunk);
        const float f[8] = {pg8::bf_lo(v.x), pg8::bf_hi(v.x), pg8::bf_lo(v.y), pg8::bf_hi(v.y), pg8::bf_lo(v.z), pg8::bf_hi(v.z), pg8::bf_lo(v.w), pg8::bf_hi(v.w)};
#pragma unroll
        for (int e = 0; e < 8; ++e) { s1[e] += f[e]; s2[e] = fmaf(f[e], f[e], s2[e]); } }
#pragma unroll
    for (int e = 0; e < 8; ++e) { red[rsub * 128 + 8 * chunk + e] = s1[e]; red[4096 + rsub * 128 + 8 * chunk + e] = s2[e]; }
    __syncthreads();
    if (tid < 128) { float t1 = 0.f, t2 = 0.f;
#pragma unroll 8
        for (int r = 0; r < 32; ++r) { t1 += red[r * 128 + tid]; t2 += red[4096 + r * 128 + tid]; }
        const float mean = t1 * (1.f / 1024.f); const float var = fmaxf(t2 * (1.f / 1024.f) - mean * mean, 0.f);
        stat[tid] = mean; stat[128 + tid] = 1.0f / sqrtf(var + LN_EPS); }
    __syncthreads();
    float mu[8], rs[8];
#pragma unroll
    for (int e = 0; e < 8; ++e) { mu[e] = stat[8 * chunk + e]; rs[e] = stat[128 + 8 * chunk + e]; }
    const int l15 = lane & 15, kq = lane >> 4;
    const size_t tokw = tok0 + 16 * wave + l15;
    for (int g = 0; g < 8; ++g) {
        v2u guv[8];
#pragma unroll
        for (int ct = 0; ct < 8; ++ct) guv[ct] = *(const v2u*)(gu + tokw * DM + g * 128 + 16 * ct + 4 * kq);
        const float bias = bs[g * 128 + 16 * wave + l15];
#pragma unroll
        for (int p = 0; p < 4; ++p) { const int rl = p * 32 + rsub; const int c = g * 128 + rl;
            const v4u v = *(const v4u*)(gvT + ((size_t)unit * 1024 + c) * 128 + 8 * chunk); const float gg = lng[c], bb = lnb[c];
            const float f[8] = {pg8::bf_lo(v.x), pg8::bf_hi(v.x), pg8::bf_lo(v.y), pg8::bf_hi(v.y), pg8::bf_lo(v.z), pg8::bf_hi(v.z), pg8::bf_lo(v.w), pg8::bf_hi(v.w)};
            float o[8];
#pragma unroll
            for (int e = 0; e < 8; ++e) o[e] = fmaf((f[e] - mu[e]) * rs[e], gg, bb);
            v4u w; w.x = pk2(o[0], o[1]); w.y = pk2(o[2], o[3]); w.z = pk2(o[4], o[5]); w.w = pk2(o[6], o[7]);
            *(LAS v4u*)(lds + SGU_B + rl * SGU_PITCH + chunk * 16) = w;
            const v4u wv = *(const v4u*)(wsgu + (size_t)(g * 128 + rl) * 128 + 8 * chunk);
            *(LAS v4u*)(lds + SGU_A + rl * SGU_PITCH + chunk * 16) = wv; }
        __syncthreads();
        const int kkmax = (16 * wave + 15) >> 5;
        f32x4 acc[8];
#pragma unroll
        for (int ct = 0; ct < 8; ++ct) acc[ct] = (f32x4){0.f, 0.f, 0.f, 0.f};
        for (int kk = 0; kk <= kkmax; ++kk) {
            const bf16x8 wf = *(const LAS bf16x8*)(lds + SGU_A + (16 * wave + l15) * SGU_PITCH + (32 * kk + 8 * kq) * 2);
#pragma unroll
            for (int ct = 0; ct < 8; ++ct) { const bf16x8 vf = *(const LAS bf16x8*)(lds + SGU_B + (16 * ct + l15) * SGU_PITCH + (32 * kk + 8 * kq) * 2);
                acc[ct] = __builtin_amdgcn_mfma_f32_16x16x32_bf16(vf, wf, acc[ct], 0, 0, 0); }
        }
#pragma unroll
        for (int ct = 0; ct < 8; ++ct) { const size_t off = tokw * DM + g * 128 + 16 * ct + 4 * kq; const v2u u = guv[ct];
            v2u w; w.x = pk2(pg8::bf_lo(u.x) * (acc[ct][0] + bias), pg8::bf_hi(u.x) * (acc[ct][1] + bias)); w.y = pk2(pg8::bf_lo(u.y) * (acc[ct][2] + bias), pg8::bf_hi(u.y) * (acc[ct][3] + bias));
            *(v2u*)(aout + off) = w; }
        __syncthreads();
    }
}

__device__ __forceinline__ unsigned short* score_base(const Args& a, int b) { return b < 7 ? (unsigned short*)a.out + (size_t)b * SCORE_BATCH_ELEMS : (unsigned short*)(a.ws + WS_S6); }
__device__ __forceinline__ size_t score_stripoff(int s) { const int a = s >> 2, r = s & 3; return (size_t)1024 * (a + 1) * (2 * a + r); }
constexpr int IDX_PITCH = 144;
constexpr int IDX_BUF = 64 * IDX_PITCH;
__device__ __forceinline__ void idx_block_item(const Args& a, LAS unsigned char* lds, int idx, int tid, int wave, int lane) {
    const bf16* qi = (const bf16*)(a.ws + WS_S4); const bf16* ki = (const bf16*)(a.ws + WS_KI); const float* wi = (const float*)(a.ws + WS_WI);
    const int b = idx / 144; int r = idx % 144; int q4 = 0;
    while (r >= 4 * (q4 + 1)) { r -= 4 * (q4 + 1); ++q4; }
    const int per = q4 + 1, j = 4 * q4 + r / per, c = r % per;
    const int ng_blk = 2 * j + 2, ng_w = 2 * j + 1 + (wave >= 4 ? 1 : 0);
    const int g_beg = 8 * c, g_end = (8 * c + 8 < ng_blk) ? 8 * c + 8 : ng_blk;
    const int t0 = 128 * j + 16 * wave;
    const int l15 = lane & 15, kq = lane >> 4;
    const size_t tok = (size_t)b * SEQ + t0 + l15;
    bf16x8 qf[8][2];
#pragma unroll
    for (int h = 0; h < 8; ++h)
#pragma unroll
        for (int kk = 0; kk < 2; ++kk) qf[h][kk] = *(const bf16x8*)(qi + tok * 512 + h * 64 + kk * 32 + kq * 8);
    const f32x4 w0 = *(const f32x4*)(wi + tok * 8), w1 = *(const f32x4*)(wi + tok * 8 + 4);
    const float wv[8] = {w0[0], w0[1], w0[2], w0[3], w1[0], w1[1], w1[2], w1[3]};
    unsigned short* sblk = score_base(a, b) + score_stripoff(t0 >> 4) + l15 * 32 + kq * 8;
    const bf16* kg = ki + ((size_t)b * SEQ + (tid >> 3)) * 64 + (tid & 7) * 8;
    const int st_off = (tid >> 3) * IDX_PITCH + (tid & 7) * 16;
    const int rd_off = (8 * (l15 >> 2) + (l15 & 3)) * IDX_PITCH + kq * 16;
    v4u stg = *(const v4u*)(kg + (size_t)(64 * g_beg) * 64);
    *(LAS v4u*)(lds + st_off) = stg;
    __syncthreads();
    v4u o0 = {0u, 0u, 0u, 0u}, o1 = {0u, 0u, 0u, 0u}; bool pend = false;
    unsigned short* pdst = sblk;
    for (int g = g_beg; g < g_end; ++g) {
        const int cur = ((g - g_beg) & 1) * IDX_BUF;
        if (g + 1 < g_end) stg = *(const v4u*)(kg + (size_t)(64 * (g + 1)) * 64);
        if (pend) { *(v4u*)pdst = o0; *(v4u*)(pdst + 512) = o1; }
        pend = g < ng_w;
        if (g < ng_w) {
            unsigned hw[8];
#pragma unroll
            for (int jt = 0; jt < 4; ++jt) {
                const bf16x8 k0 = *(const LAS bf16x8*)(lds + cur + rd_off + (32 * (jt >> 1) + 4 * (jt & 1)) * IDX_PITCH), k1 = *(const LAS bf16x8*)(lds + cur + rd_off + (32 * (jt >> 1) + 4 * (jt & 1)) * IDX_PITCH + 64);
                f32x4 sc = {0.f, 0.f, 0.f, 0.f};
#pragma unroll
                for (int h = 0; h < 8; ++h) { f32x4 C = {0.f, 0.f, 0.f, 0.f};
                    C = __builtin_amdgcn_mfma_f32_16x16x32_bf16(k0, qf[h][0], C, 0, 0, 0); C = __builtin_amdgcn_mfma_f32_16x16x32_bf16(k1, qf[h][1], C, 0, 0, 0);
#pragma unroll
                    for (int e = 0; e < 4; ++e) { int xi = __float_as_int(C[e]); xi = xi > 0 ? xi : 0; sc[e] = fmaf(wv[h], __int_as_float(xi), sc[e]); } }
                const _Float16 h0 = (_Float16)sc[0], h1 = (_Float16)sc[1], h2 = (_Float16)sc[2], h3 = (_Float16)sc[3];
                hw[2 * jt] = (unsigned)__builtin_bit_cast(unsigned short, h0) | ((unsigned)__builtin_bit_cast(unsigned short, h1) << 16);
                hw[2 * jt + 1] = (unsigned)__builtin_bit_cast(unsigned short, h2) | ((unsigned)__builtin_bit_cast(unsigned short, h3) << 16);
            }
            o0 = (v4u){hw[0], hw[1], hw[2], hw[3]}; o1 = (v4u){hw[4], hw[5], hw[6], hw[7]};
            pdst = sblk + (size_t)g * 1024;
        }
        if (g + 1 < g_end) *(LAS v4u*)(lds + (cur ^ IDX_BUF) + st_off) = stg;
        __syncthreads();
    }
    if (pend) { *(v4u*)pdst = o0; *(v4u*)(pdst + 512) = o1; }
}

typedef unsigned short u16x2 __attribute__((ext_vector_type(2)));
__device__ __forceinline__ unsigned wave_sum_small(unsigned lc) {
    unsigned cnt = 0u;
#pragma unroll
    for (int p = 0; p < 7; ++p) cnt += (unsigned)__builtin_popcountll(__ballot((lc >> p) & 1u)) << p;
    return cnt;
}
__device__ __forceinline__ void select_load(const Args& a, int row, int lane, v4u (&raw)[8]) {
    const int b = row >> 12, t = row & 4095;
    const unsigned short* sblk = score_base(a, b) + score_stripoff(t >> 4) + ((lane >> 2) & 1) * 512 + (t & 15) * 32 + (lane & 3) * 8;
    const int nch = (t >> 9) + 1;
#pragma unroll
    for (int c = 0; c < 8; ++c) { const int cc = c < nch ? c : nch - 1; raw[c] = *(const v4u*)(sblk + (size_t)(8 * cc + (lane >> 3)) * 1024); }
}
__device__ __forceinline__ void select_row(const Args& a, int row, int lane, const v4u (&raw)[8]) {
    const int t = row & 4095;
    unsigned char* mrow = (unsigned char*)(a.ws + WS_MASK) + (size_t)row * 512;
    if (t < 256) {
#pragma unroll
        for (int c = 0; c < 8; ++c) { const int base = 512 * c + 8 * lane; unsigned bits = 0;
            if (base <= t) { const int n = t - base + 1; bits = n >= 8 ? 0xffu : ((1u << n) - 1u); }
            mrow[64 * c + lane] = (unsigned char)bits; }
        return;
    }
    const int nch = (t >> 9) + 1;
    unsigned K[32];
#pragma unroll
    for (int c = 0; c < 8; ++c) {
        const unsigned h[4] = {raw[c].x, raw[c].y, raw[c].z, raw[c].w};
        const int nv = t - (512 * c + 8 * lane) + 1;
#pragma unroll
        for (int p = 0; p < 4; ++p) {
            const u16x2 hv = __builtin_bit_cast(u16x2, h[p]);
            const u16x2 sg = __builtin_bit_cast(u16x2, __builtin_bit_cast(short __attribute__((ext_vector_type(2))), hv) >> 15);
            const unsigned k = h[p] ^ (__builtin_bit_cast(unsigned, sg) | 0x80008000u);
            const unsigned vm = nv >= 2 * p + 2 ? 0xffffffffu : (nv == 2 * p + 1 ? 0x0000ffffu : 0u);
            K[4 * c + p] = k & vm; }
    }
    u16x2 acc = {0, 0};
#pragma unroll
    for (int c = 0; c < 8; ++c) if (c < nch) {
#pragma unroll
        for (int p = 0; p < 4; ++p) acc += __builtin_bit_cast(u16x2, K[4 * c + p]) >> 15; }
    const unsigned cpos = wave_sum_small((unsigned)acc.x + (unsigned)acc.y);
    const unsigned top = cpos >= 256u ? 1u : 0u, base = top ? 0u : cpos;
    bool exact = (cpos == 256u);
    unsigned k15[32];
#pragma unroll
    for (int c = 0; c < 8; ++c) {
#pragma unroll
        for (int p = 0; p < 4; ++p) { const unsigned m = __builtin_bit_cast(unsigned, __builtin_bit_cast(short __attribute__((ext_vector_type(2))), K[4 * c + p]) >> 15);
            k15[4 * c + p] = K[4 * c + p] & (top ? m : ~m) & 0x7fff7fffu; } }
    unsigned T15 = 0u;
    if (!exact) {
        for (int bit = 14; bit >= 0; --bit) {
            const unsigned cand = T15 | (1u << bit);
            const unsigned A = (0x8000u - cand) * 0x10001u;
            u16x2 ac[4] = {{0, 0}, {0, 0}, {0, 0}, {0, 0}};
#pragma unroll
            for (int c = 0; c < 8; ++c) if (c < nch) {
#pragma unroll
                for (int p = 0; p < 4; ++p) ac[p] += __builtin_bit_cast(u16x2, k15[4 * c + p] + A) >> 15; }
            const u16x2 at = (ac[0] + ac[1]) + (ac[2] + ac[3]);
            const unsigned cnt = base + wave_sum_small((unsigned)at.x + (unsigned)at.y);
            if (cnt >= 256u) { T15 = cand; if (cnt == 256u) { exact = true; break; } }
        }
    }
    const unsigned T = (top << 15) | T15;
    unsigned need = 0u;
    if (!exact) {
        const unsigned A = (0x8000u - (T15 + 1u)) * 0x10001u;
        u16x2 ac = {0, 0};
#pragma unroll
        for (int c = 0; c < 8; ++c) if (c < nch) {
#pragma unroll
            for (int p = 0; p < 4; ++p) ac += __builtin_bit_cast(u16x2, k15[4 * c + p] + A) >> 15; }
        const unsigned cgt = base + wave_sum_small((unsigned)ac.x + (unsigned)ac.y);
        need = 256u - cgt; }
#pragma unroll
    for (int c = 0; c < 8; ++c) {
        unsigned bits = 0u;
        if (c < nch) {
            unsigned eqb = 0u, gtb = 0u;
#pragma unroll
            for (int p = 0; p < 4; ++p) { const unsigned k0 = K[4 * c + p] & 0xffffu, k1 = K[4 * c + p] >> 16;
                eqb |= (k0 == T ? 1u : 0u) << (2 * p); eqb |= (k1 == T ? 1u : 0u) << (2 * p + 1);
                gtb |= (k0 > T ? 1u : 0u) << (2 * p); gtb |= (k1 > T ? 1u : 0u) << (2 * p + 1); }
            if (exact) bits = eqb | gtb;
            else if (need == 0u || __ballot(eqb != 0u) == 0ull) bits = gtb;
            else {
                unsigned before = 0u, tot = 0u;
#pragma unroll
                for (int e = 0; e < 8; ++e) { const unsigned long long m = __ballot((eqb >> e) & 1u);
                    before += __builtin_amdgcn_mbcnt_hi((unsigned)(m >> 32), __builtin_amdgcn_mbcnt_lo((unsigned)m, 0u)); tot += (unsigned)__builtin_popcountll(m); }
                unsigned sel = 0u, run = before;
#pragma unroll
                for (int e = 0; e < 8; ++e) { if ((eqb >> e) & 1u) { if (run < need) sel |= 1u << e; ++run; } }
                bits = gtb | sel;
                need = need > tot ? need - tot : 0u;
            }
        }
        mrow[64 * c + lane] = (unsigned char)bits;
    }
}
__device__ __forceinline__ void select_rows(const Args& a, int gw, int NGW, int lane) {
    v4u raw[8], cur[8];
    select_load(a, gw, lane, raw);
    for (int row = gw; row < TOK; row += NGW) {
#pragma unroll
        for (int c = 0; c < 8; ++c) cur[c] = raw[c];
        const int nrow = row + NGW < TOK ? row + NGW : row;
        select_load(a, nrow, lane, raw);
        select_row(a, row, lane, cur);
    }
}

__device__ __forceinline__ void ln_rows(float* y, bf16* bcopy, const float* g, const float* bta, int gw, int NGW, int lane) {
    f32x4 nx[4];
    { const f32x4* yr = (const f32x4*)(y + (size_t)gw * DM) + lane;
#pragma unroll
      for (int j = 0; j < 4; ++j) nx[j] = yr[64 * j]; }
    f32x4 gg[4], bb[4];
#pragma unroll
    for (int j = 0; j < 4; ++j) { gg[j] = ((const f32x4*)g)[lane + 64 * j]; bb[j] = ((const f32x4*)bta)[lane + 64 * j]; }
    for (int m = gw; m < TOK; m += NGW) {
        f32x4 v[4]; float s = 0.f;
#pragma unroll
        for (int j = 0; j < 4; ++j) { v[j] = nx[j]; s += (v[j].x + v[j].y) + (v[j].z + v[j].w); }
        { const int mn = m + NGW < TOK ? m + NGW : m; const f32x4* yr = (const f32x4*)(y + (size_t)mn * DM) + lane;
#pragma unroll
          for (int j = 0; j < 4; ++j) nx[j] = yr[64 * j]; }
        const float mean = wave_sum(s) * (1.f / DM); float s2 = 0.f;
#pragma unroll
        for (int j = 0; j < 4; ++j) { v[j] = v[j] - mean; s2 += (v[j].x * v[j].x + v[j].y * v[j].y) + (v[j].z * v[j].z + v[j].w * v[j].w); }
        const float rstd = 1.f / sqrtf(wave_sum(s2) * (1.f / DM) + LN_EPS);
        float* orow = y + (size_t)m * DM;
#pragma unroll
        for (int j = 0; j < 4; ++j) { const f32x4 o = v[j] * rstd * gg[j] + bb[j]; ((f32x4*)orow)[lane + 64 * j] = o;
            if (bcopy) { v2u w; w.x = pk2(o.x, o.y); w.y = pk2(o.z, o.w); ((v2u*)(bcopy + (size_t)m * DM))[lane + 64 * j] = w; } }
    }
}

constexpr int N_PHASES = 12;
__global__ void __launch_bounds__(NWAVES * 64, 2) hybrid_fwd(Args args) {
    extern __shared__ __attribute__((aligned(16))) unsigned char lds_raw[];
    LAS unsigned char* lds = (LAS unsigned char*)lds_raw;
    volatile LAS unsigned* MISC = (volatile LAS unsigned*)(lds + MISC_OFF);
    const int tid = threadIdx.x, lane = tid & 63, wave = __builtin_amdgcn_readfirstlane(tid >> 6);
    const int G = gridDim.x, bx = blockIdx.x;
    const int vcu = (G % 8 == 0) ? (bx % 8) * (G / 8) + bx / 8 : bx;
    const int gw = vcu * NWAVES + wave, NGW = G * NWAVES;
    unsigned char* ws = args.ws;
    unsigned* ctl = (unsigned*)(ws + WS_CTL);
    for (int u = tid; u < (LDS_BYTES - LDSCTL_OFF) / 4; u += NWAVES * 64) ((LAS unsigned*)(lds + LDSCTL_OFF))[u] = 0u;
    __syncthreads();
    XcdBarrier bar; bar.bar = ctl + CW_BAR; bar.x = 0; bar.st = nullptr;
    const int lo = args.ph_lo, hi = args.ph_hi;
    const bool use_bar = (hi - lo) > 1;
    if (use_bar) bar = xcd_barrier_post(ctl + CW_BAR, MISC + 8);
#define IN(k) (((PH_MASK >> (k)) & 1) && lo <= (k) && (k) < hi)
#define SEAM(k) do { if (IN(k) && IN((k) + 1)) xcd_barrier(bar); } while (0)

#define DUP(id, ...) if (DUP_PHASE == (id)) { __VA_ARGS__ xcd_barrier(bar); }
#define NREP(id) (DUP_PHASE == (id) ? 2 : 1)
    if (IN(0)) { DUP(0, p0_prologue(args, lds, gw, NGW, wave, lane);) p0_prologue(args, lds, gw, NGW, wave, lane); }
    SEAM(0);
#define P1_BODY { InProjSched S; S.X = (const char*)(ws + WS_S0); S.W = (const char*)(ws + WS_WIN); S.mode = 1; S.init(TOK / 256, 15, G, bx); \
        EpiInProj E{ws}; pg8::gemm_phase<EpiInProj, InProjSched, true>(lds + RING_OFF, DM, S, E); }
    if (IN(1)) { DUP(1, P1_BODY) P1_BODY }
    SEAM(1);
#define P2A_BODY { for (int u = bx; u < TOK / 128; u += G) sgu_unit(args, lds, u, tid, wave, lane); }
#define P2B_BODY { for (int it = bx; it < 8 * 144; it += G) idx_block_item(args, lds, it, tid, wave, lane); }
    if (IN(2)) { DUP(20, P2A_BODY) DUP(21, P2B_BODY) P2A_BODY P2B_BODY }
    SEAM(2);
#define P3A_BODY { select_rows(args, gw, NGW, lane); __syncthreads(); }
#define P3B_BODY { pg8::PlainSched S; S.setup(ws + WS_S5, ws + WS_WA, TOK, DM, DM, G, bx); \
        EpiGate1 E{(const bf16*)(ws + WS_S3), (bf16*)(ws + WS_S1)}; pg8::gemm_phase<EpiGate1, pg8::PlainSched, true>(lds + RING_OFF, DM, S, E); }
    if (IN(3)) { DUP(30, P3A_BODY) DUP(31, P3B_BODY) P3A_BODY P3B_BODY }
    SEAM(3);
#define P4_BODY { InProjSched S; S.X = (const char*)(ws + WS_S0); S.W = (const char*)(ws + WS_WIN); S.mode = 2; S.init(TOK / 256, 16, G, bx); \
        EpiInProj E{ws}; pg8::gemm_phase<EpiInProj, InProjSched, true>(lds + RING_OFF, DM, S, E); }
    if (IN(4)) { DUP(4, P4_BODY) P4_BODY }
    SEAM(4);
#define P5_BODY { att::attn_phase((char*)lds_raw + RING_OFF, (const att::bf16*)(ws + WS_S2), (const att::bf16*)(ws + WS_S3), (const att::bf16*)(ws + WS_S4), (att::bf16*)(ws + WS_S6), \
                                 (const unsigned long long*)(ws + WS_MASK), bx, G); }
    if (IN(5)) { P5_BODY }
    SEAM(5);
    if (IN(6)) { pg8::PlainSched S; S.setup(ws + WS_S6, ws + WS_WB, TOK, DM, DM, G, bx);
        EpiGate2 E{(const bf16*)(ws + WS_S5), (bf16*)(ws + WS_S1)}; pg8::gemm_phase<EpiGate2, pg8::PlainSched, true>(lds + RING_OFF, DM, S, E); }
    SEAM(6);
#define P7_BODY { pg8::PlainSched S; S.setup(ws + WS_S1, ws + WS_WO, TOK, DM, DM, G, bx); \
        EpiResF32 E{args.in[0], args.out}; pg8::gemm_phase<EpiResF32, pg8::PlainSched, true>(lds + RING_OFF, DM, S, E); }
    if (IN(7)) { DUP(7, P7_BODY) P7_BODY }
    SEAM(7);
    if (IN(8)) { ln_rows(args.out, (bf16*)(ws + WS_S0), args.in[9], args.in[10], gw, NGW, lane); }
    SEAM(8);
#define P9_BODY { pg8::PlainSched S; S.setup(ws + WS_S0, ws + WS_WUP, TOK, FF, DM, G, bx); \
        EpiRelu2 E{(bf16*)(ws + WS_S3)}; pg8::gemm_phase<EpiRelu2, pg8::PlainSched, true>(lds + RING_OFF, DM, S, E); }
    if (IN(9)) { DUP(9, P9_BODY) P9_BODY }
    SEAM(9);
    if (IN(10)) { pg8::PlainSched S; S.setup(ws + WS_S3, ws + WS_WDN, TOK, DM, FF, G, bx);
        EpiResF32 E{args.out, args.out}; pg8::gemm_phase<EpiResF32, pg8::PlainSched, true>(lds + RING_OFF, FF, S, E); }
    SEAM(10);
    if (IN(11)) { ln_rows(args.out, nullptr, args.in[13], args.in[14], gw, NGW, lane); }
#undef IN
#undef SEAM
}

extern "C" void kernel_launch(void* const* d_in, const int* in_sizes, int n_in, void* d_out, int out_size, void* d_ws, size_t ws_size, hipStream_t stream) {
    static int grid = 0;
    if (grid == 0) {
        if (n_in != 15 || in_sizes[0] != TOK * DM || out_size != TOK * DM || ws_size < WS_END) { fprintf(stderr, "kernel_launch: unexpected shapes (n_in %d, in0 %d, out %d, ws %zu)\n", n_in, n_in > 0 ? in_sizes[0] : -1, out_size, ws_size); grid = -1; return; }
        int dev = 0, cus = 0, per_cu = 0;
        if (hipGetDevice(&dev) != hipSuccess || hipDeviceGetAttribute(&cus, hipDeviceAttributeMultiprocessorCount, dev) != hipSuccess) { grid = -1; return; }
        if (hipFuncSetAttribute((const void*)hybrid_fwd, hipFuncAttributeMaxDynamicSharedMemorySize, LDS_BYTES) != hipSuccess) { fprintf(stderr, "kernel_launch: hipFuncSetAttribute failed\n"); grid = -1; return; }
        if (hipOccupancyMaxActiveBlocksPerMultiprocessor(&per_cu, (const void*)hybrid_fwd, NWAVES * 64, LDS_BYTES) != hipSuccess || per_cu < 1) { fprintf(stderr, "kernel_launch: occupancy query says %d blocks per CU\n", per_cu); (void)hipGetLastError(); grid = -1; return; }
        grid = cus;
    }
    if (grid < 0) return;
    (void)hipMemsetAsync((char*)d_ws + WS_CTL, 0, CTL_ZERO_BYTES, stream);
    Args a{};
    for (int i = 0; i < 15; ++i) a.in[i] = (const float*)d_in[i];
    a.out = (float*)d_out; a.ws = (unsigned char*)d_ws;
#if MK_N_LAUNCHES == 1
    a.ph_lo = 0; a.ph_hi = N_PHASES;
    void* kargs[] = {&a};
    hipError_t e = hipLaunchCooperativeKernel((const void*)hybrid_fwd, dim3(grid), dim3(NWAVES * 64), kargs, LDS_BYTES, stream);
    if (e != hipSuccess) fprintf(stderr, "kernel_launch: cooperative launch failed: %s (grid %d)\n", hipGetErrorString(e), grid);
#else
    for (int p = 0; p < N_PHASES; ++p) { a.ph_lo = p; a.ph_hi = p + 1; hipLaunchKernelGGL(hybrid_fwd, dim3(grid), dim3(NWAVES * 64), LDS_BYTES, stream, a); }
#endif
}
```
